# Optimizing an MI355X kernel written in HIP

```python
import jax, jax.numpy as jnp
from jax import lax
import numpy as np

D_MODEL = 1024
BATCH = 16
SEQ = 2048
DEPTH = 2

N_META = 16
POOL_WINDOWS = (2, 4, 8, 16)
POOL_GROUP = 128
POOL_WIDTH = POOL_GROUP * len(POOL_WINDOWS)
N_HEADS = 16
QK_NOPE = 64
QK_ROPE = 32
V_DIM = 64
Q_RANK = 256
KV_RANK = 128
QK_DIM = QK_NOPE + QK_ROPE
ATT_WIDTH = N_HEADS * V_DIM
SM_SCALE = QK_DIM ** -0.5
ROPE_THETA = 10000.0
Q_BLOCK = 128
D_FF = -(-8 * D_MODEL // (3 * 256)) * 256
NORM_EPS = 1e-6
MASK_VALUE = -1e30
IN_SIZES = (POOL_WIDTH, Q_RANK, KV_RANK, QK_ROPE, D_MODEL, D_MODEL)
D_IN = POOL_WIDTH + Q_RANK + KV_RANK + QK_ROPE + 2 * D_MODEL
IN_OFFSETS = (POOL_WIDTH,
              POOL_WIDTH + Q_RANK,
              POOL_WIDTH + Q_RANK + KV_RANK,
              POOL_WIDTH + Q_RANK + KV_RANK + QK_ROPE,
              POOL_WIDTH + Q_RANK + KV_RANK + QK_ROPE + D_MODEL)

kernel_name = "hybrid_pool_mla_gated_block"


def rmsnorm(x, g):
    xf = x.astype(jnp.float32)
    y = xf * lax.rsqrt(jnp.mean(xf * xf, axis=-1, keepdims=True) + NORM_EPS)
    return (y * g.astype(jnp.float32)).astype(x.dtype)


def rope_tables(length):
    inv = 1.0 / (ROPE_THETA ** (jnp.arange(0, QK_ROPE, 2, dtype=jnp.float32) / QK_ROPE))
    ang = jnp.arange(length, dtype=jnp.float32)[:, None] * inv[None, :]
    return jnp.cos(ang), jnp.sin(ang)


def apply_rope(x, cos, sin):
    xf = x.astype(jnp.float32)
    x1, x2 = jnp.split(xf, 2, axis=-1)
    out = jnp.concatenate([x1 * cos - x2 * sin, x1 * sin + x2 * cos], axis=-1)
    return out.astype(x.dtype)


def pool_mixer(u, pool_w, pool_scale):
    B, L, _ = u.shape
    cs = jnp.cumsum(u.astype(jnp.float32), axis=1)
    cs0 = jnp.concatenate([jnp.zeros((B, 1, POOL_WIDTH), jnp.float32), cs], axis=1)
    t = jnp.arange(L, dtype=jnp.float32)[:, None]
    groups = []
    for g, w in enumerate(POOL_WINDOWS):
        c = cs0[:, :, g * POOL_GROUP:(g + 1) * POOL_GROUP]
        prev = jnp.pad(c[:, :L + 1 - w], ((0, 0), (w, 0), (0, 0)))
        wsum = (c - prev)[:, 1:]
        count = jnp.minimum(t + 1.0, float(w))
        ug = u[:, :, g * POOL_GROUP:(g + 1) * POOL_GROUP].astype(jnp.float32)
        groups.append(wsum / count - ug)
    y = jnp.stack(groups, axis=2).astype(u.dtype)
    y = jnp.einsum('blgc,gcd->blgd', y, pool_w).reshape(B, L, POOL_WIDTH)
    return y * pool_scale


def mla_attention(q_nope, q_rope, k_nope, k_rope, v):
    L = q_nope.shape[1]
    outs = []
    for start in range(0, L, Q_BLOCK):
        end = min(start + Q_BLOCK, L)
        s = (jnp.einsum('bqhd,bkhd->bhqk', q_nope[:, start:end], k_nope[:, :end])
             + jnp.einsum('bqhr,bkr->bhqk', q_rope[:, start:end], k_rope[:, :end]))
        s = s.astype(jnp.float32) * SM_SCALE
        mask = jnp.arange(end)[None, :] <= jnp.arange(start, end)[:, None]
        s = jnp.where(mask[None, None], s, MASK_VALUE)
        p = jax.nn.softmax(s, axis=-1).astype(v.dtype)
        outs.append(jnp.einsum('bhqk,bkhd->bqhd', p, v[:, :end]))
    return jnp.concatenate(outs, axis=1)


def hybrid_layer(h, cos, sin, g_mix, w_in, pool_w, pool_scale, q_norm_g, kv_norm_g, w_uq, w_ukv,
                 w_pa, w_pb, w_o, g_ffn, w_gate, w_up, w_down):
    B, L, _ = h.shape
    hn = rmsnorm(h, g_mix)
    z = hn @ w_in
    u, c_q, c_kv, k_rope, gate_a, gate_b = jnp.split(z, IN_OFFSETS, axis=-1)
    a = pool_mixer(u, pool_w, pool_scale)
    q = (rmsnorm(c_q, q_norm_g) @ w_uq).reshape(B, L, N_HEADS, QK_DIM)
    q_nope, q_rope = q[..., :QK_NOPE], q[..., QK_NOPE:]
    q_rope = apply_rope(q_rope, cos[:, None, :], sin[:, None, :])
    kv = (rmsnorm(c_kv, kv_norm_g) @ w_ukv).reshape(B, L, N_HEADS, QK_NOPE + V_DIM)
    k_nope, v = kv[..., :QK_NOPE], kv[..., QK_NOPE:]
    k_rope = apply_rope(k_rope, cos, sin)
    b = mla_attention(q_nope, q_rope, k_nope, k_rope, v).reshape(B, L, ATT_WIDTH)
    merged = jax.nn.sigmoid(gate_a) * (a @ w_pa) + jax.nn.sigmoid(gate_b) * (b @ w_pb)
    h = h + merged @ w_o
    hn = rmsnorm(h, g_ffn)
    h = h + (jax.nn.silu(hn @ w_gate) * (hn @ w_up)) @ w_down
    return h


def setup_inputs(seed: int = 0) -> dict:
    key = jax.random.key(seed)
    ks = jax.random.split(key, 20)

    def w(k, shape, fan_in):
        return jax.random.normal(k, shape, jnp.float32) * (fan_in ** -0.5)

    def gain(k, shape):
        return 1.0 + 0.05 * jax.random.normal(k, shape, jnp.float32)

    return {
        "x": jax.random.normal(ks[0], (BATCH, SEQ, D_MODEL), jnp.float32),
        "meta_tokens": jax.random.normal(ks[1], (N_META, D_MODEL), jnp.float32),
        "norm_mix_g": gain(ks[2], (DEPTH, D_MODEL)),
        "w_in": w(ks[3], (DEPTH, D_MODEL, D_IN), D_MODEL),
        "pool_w": w(ks[4], (DEPTH, len(POOL_WINDOWS), POOL_GROUP, POOL_GROUP), POOL_GROUP),
        "pool_scale": gain(ks[5], (DEPTH, POOL_WIDTH)),
        "q_norm_g": gain(ks[6], (DEPTH, Q_RANK)),
        "kv_norm_g": gain(ks[7], (DEPTH, KV_RANK)),
        "w_uq": w(ks[8], (DEPTH, Q_RANK, N_HEADS * QK_DIM), Q_RANK),
        "w_ukv": w(ks[9], (DEPTH, KV_RANK, N_HEADS * (QK_NOPE + V_DIM)), KV_RANK),
        "w_pa": w(ks[10], (DEPTH, POOL_WIDTH, D_MODEL), POOL_WIDTH),
        "w_pb": w(ks[11], (DEPTH, ATT_WIDTH, D_MODEL), ATT_WIDTH),
        "w_o": w(ks[12], (DEPTH, D_MODEL, D_MODEL), D_MODEL),
        "norm_ffn_g": gain(ks[13], (DEPTH, D_MODEL)),
        "w_gate": w(ks[14], (DEPTH, D_MODEL, D_FF), D_MODEL),
        "w_up": w(ks[15], (DEPTH, D_MODEL, D_FF), D_MODEL),
        "w_down": w(ks[16], (DEPTH, D_FF, D_MODEL), D_FF),
        "final_norm_g": gain(ks[17], (D_MODEL,)),
    }


def reference(x, meta_tokens, norm_mix_g, w_in, pool_w, pool_scale, q_norm_g, kv_norm_g, w_uq, w_ukv,
              w_pa, w_pb, w_o, norm_ffn_g, w_gate, w_up, w_down, final_norm_g):
    B = x.shape[0]
    meta = jnp.broadcast_to(meta_tokens.astype(x.dtype)[None], (B, N_META, D_MODEL))
    h = jnp.concatenate([meta, x], axis=1)
    cos, sin = rope_tables(h.shape[1])
    for i in range(DEPTH):
        h = hybrid_layer(h, cos, sin, norm_mix_g[i], w_in[i], pool_w[i], pool_scale[i], q_norm_g[i],
                         kv_norm_g[i], w_uq[i], w_ukv[i], w_pa[i], w_pb[i], w_o[i], norm_ffn_g[i],
                         w_gate[i], w_up[i], w_down[i])
    return rmsnorm(h, final_norm_g)[:, N_META:]
```

```cpp
#include <hip/hip_runtime.h>
#include <hip/hip_cooperative_groups.h>
#include <cstdio>
#include <cstdint>
#include <cmath>
namespace cg = cooperative_groups;
namespace pg8 {
#define PG8_LAS __attribute__((address_space(3)))
typedef unsigned short bf16_t;
typedef short bf16x8 __attribute__((ext_vector_type(8)));
typedef float f32x4 __attribute__((ext_vector_type(4)));
typedef unsigned u32x4 __attribute__((ext_vector_type(4)));
constexpr int BM = 256, BK = 64, HALF = 128, HTB = HALF * BK * 2  , STAGE_BYTES = 8 * HTB, NXCD = 8, WGM = 8;

__host__ __device__ __forceinline__ int lds_byte(int r, int c) { const int st = (r >> 4) * 2 + (c >> 5), rr = r & 15, cc = c & 31, ob = rr * 64 + cc * 2; return st * 1024 + (ob ^ (((ob >> 9) & 1) << 5)); }
__host__ __device__ __forceinline__ void stage_rc(int b, int& R, int& C) { const int st = b / 1024, sb = b % 1024, swz = sb ^ (((sb >> 9) & 1) << 5); R = (st >> 1) * 16 + swz / 64; C = (st & 1) * 32 + (swz % 64) / 2; }
__host__ __device__ __forceinline__ int perm32(int rho) { const int n = rho >> 4, i = rho & 15; return 8 * (i >> 2) + 4 * n + (i & 3); }

struct Unit { int pm, pn; };
struct Gemm { const bf16_t* A; const bf16_t* Bt; int M, N, K; };

struct StaticOrder {
    int nM, nN, nwg, G, c;
    __host__ __device__ void init(int M, int N, int G_, int c_) { nM = M / BM; nN = N / BM; nwg = nM * nN; G = G_; c = c_; }
    __host__ __device__ bool next(int i, Unit& u) const {
        const long L = (long)i * G + c; if (L >= nwg) return false;
        int wgid = (int)L; { const int q = nwg / NXCD, r = nwg % NXCD, xcd = wgid % NXCD, off = wgid / NXCD; wgid = (xcd < r ? xcd * (q + 1) : r * (q + 1) + (xcd - r) * q) + off; }
        const int nig = WGM * nN, gid = wgid / nig, fm = gid * WGM, gsz = (nM - fm) < WGM ? (nM - fm) : WGM;
        u.pm = fm + ((wgid % nig) % gsz); u.pn = (wgid % nig) / gsz; return true;
    }
    __device__ __forceinline__ void a_ready(const Unit&) const {}
    __device__ __forceinline__ void done(const Unit&) const {}
};

template <class Epi, class Sched, bool ALIGN_EPI = false, bool SP2 = false>
__device__ __forceinline__ void gemm_phase(PG8_LAS unsigned char* lds, const Gemm g, const Sched& S, const Epi& E) {
    int tid_ = threadIdx.x; asm volatile("" : "+v"(tid_));
    const int tid = tid_, wid = __builtin_amdgcn_readfirstlane(tid >> 6), lane = tid & 63, wr = wid >> 2, wc = wid & 3, fr = lane & 15, fq = lane >> 4;
    int K_ = g.K; asm volatile("" : "+s"(K_));
    const int K = K_, nt = K / BK;
    unsigned voffA[2], voffB[2];
#pragma unroll
    for (int i = 0; i < 2; ++i) { int R, C; stage_rc(tid * 16 + i * 8192, R, C); const int Rb = Epi::PERM ? ((R & ~31) + perm32(R & 31)) : R;
        voffA[i] = (unsigned)(R * K + C) * 2u; voffB[i] = (unsigned)(Rb * K + C) * 2u; }
    const size_t kstep = (size_t)(BK * 2);
    const size_t hstep = (size_t)HALF * K * 2;
    const size_t tstep = 2 * hstep;
    const unsigned ldsw = (unsigned)wid * 1024u;
    const int aoff = lds_byte(wr * 64 + fr, fq * 8), boff = lds_byte(wc * 32 + fr, fq * 8);
#define PG8_SA(b, h) (((b) * 2 + (h)) * HTB)
#define PG8_SB(b, h) ((4 + (b) * 2 + (h)) * HTB)
#define PG8_STAGE(bufoff, gbase, voff) do { _Pragma("unroll") for (int _i = 0; _i < 2; ++_i) \
        __builtin_amdgcn_global_load_lds((const unsigned*)((const char*)(gbase) + (voff)[_i]), (PG8_LAS unsigned*)(lds + (bufoff) + ldsw + _i * 8192), 16, 0, 0); } while (0)
#define PG8_LDA(dst, b, h) do { _Pragma("unroll") for (int m = 0; m < 4; ++m) _Pragma("unroll") for (int k = 0; k < 2; ++k) dst[m][k] = *(const PG8_LAS bf16x8*)(lds + PG8_SA(b, h) + aoff + m * 2048 + k * 1024); } while (0)
#define PG8_LDB(dst, b, h) do { _Pragma("unroll") for (int n = 0; n < 2; ++n) _Pragma("unroll") for (int k = 0; k < 2; ++k) dst[n][k] = *(const PG8_LAS bf16x8*)(lds + PG8_SB(b, h) + boff + n * 2048 + k * 1024); } while (0)
#define PG8_MMA(ai, bj, At, Bt) do { __builtin_amdgcn_s_setprio(1); _Pragma("unroll") for (int m = 0; m < 4; ++m) _Pragma("unroll") for (int n = 0; n < 2; ++n) _Pragma("unroll") for (int k = 0; k < 2; ++k) \
        acc[ai][bj][m][n] = __builtin_amdgcn_mfma_f32_16x16x32_bf16(Bt[n][k], At[m][k], acc[ai][bj][m][n], 0, 0, 0); __builtin_amdgcn_s_setprio(0); } while (0)
#define PG8_WAIT_V(n) asm volatile("s_waitcnt vmcnt(" #n ")" ::: "memory")
#define PG8_WAIT_L(n) asm volatile("s_waitcnt lgkmcnt(" #n ")" ::: "memory")
#define PG8_BAR __builtin_amdgcn_s_barrier()
#define PG8_SCHED __builtin_amdgcn_sched_barrier(0)
    Unit cur, nxt; int ui = 0;
    if (!S.next(0, cur)) return;
    f32x4 acc[2][2][4][2];
#pragma unroll
    for (int a = 0; a < 2; ++a)
#pragma unroll
        for (int b = 0; b < 2; ++b)
#pragma unroll
            for (int m = 0; m < 4; ++m)
#pragma unroll
                for (int n = 0; n < 2; ++n) acc[a][b][m][n] = (f32x4){0.f, 0.f, 0.f, 0.f};
    bf16x8 At[4][2], B0[2][2], B1[2][2];
    const char* cA = (const char*)g.A + (size_t)cur.pm * tstep; const char* cB = (const char*)g.Bt + (size_t)cur.pn * tstep;
    S.a_ready(cur);
    if constexpr (SP2) {
        PG8_STAGE(PG8_SB(0, 0), cB, voffB); PG8_STAGE(PG8_SB(0, 1), cB + hstep, voffB); PG8_STAGE(PG8_SA(0, 0), cA, voffA); PG8_STAGE(PG8_SA(0, 1), cA + hstep, voffA);
        if (wr == 1) PG8_BAR;
        PG8_WAIT_V(2); PG8_BAR;
        PG8_STAGE(PG8_SB(1, 0), cB + kstep, voffB); PG8_STAGE(PG8_SA(1, 0), cA + kstep, voffA); PG8_STAGE(PG8_SB(1, 1), cB + hstep + kstep, voffB);
        PG8_WAIT_V(6); PG8_BAR;
    } else {
        PG8_STAGE(PG8_SB(0, 0), cB, voffB); PG8_STAGE(PG8_SA(0, 0), cA, voffA); PG8_STAGE(PG8_SB(0, 1), cB + hstep, voffB); PG8_STAGE(PG8_SA(0, 1), cA + hstep, voffA);
        if (wr == 1) PG8_BAR;
        PG8_WAIT_V(4); PG8_BAR;
        PG8_STAGE(PG8_SB(1, 0), cB + kstep, voffB); PG8_STAGE(PG8_SA(1, 0), cA + kstep, voffA); PG8_STAGE(PG8_SB(1, 1), cB + hstep + kstep, voffB);
        PG8_WAIT_V(6); PG8_BAR;
    }
    for (;;) {
        const bool has_next = S.next(ui + 1, nxt);
        const char* nA = has_next ? (const char*)g.A + (size_t)nxt.pm * tstep : cA; const char* nB = has_next ? (const char*)g.Bt + (size_t)nxt.pn * tstep : cB;
        for (int t = 0; t < nt; t += 2) {
            const bool last = (t == nt - 2);
            const char* a1 = cA + (size_t)(t + 1) * kstep;
            const char* a2 = last ? nA : cA + (size_t)(t + 2) * kstep; const char* b2 = last ? nB : cB + (size_t)(t + 2) * kstep;
            const char* a3 = a2 + kstep; const char* b3 = b2 + kstep;
            if (last && has_next) S.a_ready(nxt);
            if constexpr (SP2) {
            PG8_LDB(B0, 0, 0); PG8_LDB(B1, 0, 1); PG8_SCHED; PG8_LDA(At, 0, 0); PG8_STAGE(PG8_SA(1, 1), a1 + hstep, voffA);
            PG8_WAIT_V(8); PG8_WAIT_L(0); PG8_BAR; PG8_MMA(0, 0, At, B0); PG8_MMA(0, 1, At, B1); PG8_BAR; PG8_SCHED;
            PG8_LDA(At, 0, 1); PG8_STAGE(PG8_SB(0, 0), b2, voffB); PG8_STAGE(PG8_SB(0, 1), b2 + hstep, voffB); PG8_STAGE(PG8_SA(0, 0), a2, voffA);
            PG8_WAIT_V(8); PG8_WAIT_L(0); PG8_BAR; PG8_MMA(1, 0, At, B0); PG8_MMA(1, 1, At, B1); PG8_BAR; PG8_SCHED;
            PG8_LDB(B0, 1, 0); PG8_LDB(B1, 1, 1); PG8_SCHED; PG8_LDA(At, 1, 0); PG8_STAGE(PG8_SA(0, 1), a2 + hstep, voffA);
            PG8_WAIT_V(8); PG8_WAIT_L(0); PG8_BAR; PG8_MMA(0, 0, At, B0); PG8_MMA(0, 1, At, B1); PG8_BAR; PG8_SCHED;
            PG8_LDA(At, 1, 1); PG8_STAGE(PG8_SB(1, 0), b3, voffB); PG8_STAGE(PG8_SB(1, 1), b3 + hstep, voffB); PG8_STAGE(PG8_SA(1, 0), a3, voffA);
            PG8_WAIT_V(8); PG8_WAIT_L(0); PG8_BAR; PG8_MMA(1, 0, At, B0); PG8_MMA(1, 1, At, B1); PG8_BAR; PG8_SCHED;
            } else {
            PG8_LDB(B0, 0, 0); PG8_SCHED; PG8_LDA(At, 0, 0); PG8_STAGE(PG8_SA(1, 1), a1 + hstep, voffA);
            PG8_WAIT_L(8); PG8_BAR; PG8_WAIT_L(0); PG8_MMA(0, 0, At, B0); PG8_BAR; PG8_SCHED;
            PG8_LDB(B1, 0, 1); PG8_STAGE(PG8_SB(0, 0), b2, voffB);
            PG8_BAR; PG8_WAIT_L(0); PG8_MMA(0, 1, At, B1); PG8_BAR;
            PG8_LDA(At, 0, 1); PG8_STAGE(PG8_SA(0, 0), a2, voffA);
            PG8_BAR; PG8_WAIT_L(0); PG8_MMA(1, 0, At, B0); PG8_BAR; PG8_SCHED;
            PG8_STAGE(PG8_SB(0, 1), b2 + hstep, voffB);
            PG8_WAIT_V(6); PG8_BAR; PG8_MMA(1, 1, At, B1); PG8_BAR;
            PG8_LDB(B0, 1, 0); PG8_SCHED; PG8_LDA(At, 1, 0); PG8_STAGE(PG8_SA(0, 1), a2 + hstep, voffA);
            PG8_WAIT_L(8); PG8_BAR; PG8_WAIT_L(0); PG8_MMA(0, 0, At, B0); PG8_BAR; PG8_SCHED;
            PG8_LDB(B1, 1, 1); PG8_STAGE(PG8_SB(1, 0), b3, voffB);
            PG8_BAR; PG8_WAIT_L(0); PG8_MMA(0, 1, At, B1); PG8_BAR;
            PG8_LDA(At, 1, 1); PG8_STAGE(PG8_SA(1, 0), a3, voffA);
            PG8_BAR; PG8_WAIT_L(0); PG8_MMA(1, 0, At, B0); PG8_BAR; PG8_SCHED;
            PG8_STAGE(PG8_SB(1, 1), b3 + hstep, voffB);
            PG8_WAIT_V(6); PG8_BAR; PG8_MMA(1, 1, At, B1); PG8_BAR;
            }
        }
        if constexpr (ALIGN_EPI) { if (wr == 0) PG8_BAR; }
        if constexpr (!Epi::AFTER_DRAIN) { E(acc, cur, wr, wc, fr, fq); S.done(cur); }
        if (!has_next) break;
#pragma unroll
        for (int a = 0; a < 2; ++a)
#pragma unroll
            for (int b = 0; b < 2; ++b)
#pragma unroll
                for (int m = 0; m < 4; ++m)
#pragma unroll
                    for (int n = 0; n < 2; ++n) acc[a][b][m][n] = (f32x4){0.f, 0.f, 0.f, 0.f};
        cur = nxt; cA = nA; cB = nB; ++ui;
        if constexpr (ALIGN_EPI) { if (wr == 1) PG8_BAR; }
    }
    PG8_WAIT_V(0);
    if constexpr (!ALIGN_EPI) { if (wr == 0) PG8_BAR; }
    PG8_BAR;
    if constexpr (Epi::AFTER_DRAIN) { E.fused(acc, cur, wr, wc, fr, fq, lds, wid, lane); S.done(cur); }
#undef PG8_SA
#undef PG8_SB
#undef PG8_STAGE
#undef PG8_LDA
#undef PG8_LDB
#undef PG8_MMA
#undef PG8_WAIT_V
#undef PG8_WAIT_L
#undef PG8_BAR
#undef PG8_SCHED
}
}
#define LAS __attribute__((address_space(3)))
typedef unsigned short bf16;
typedef float f32x4 __attribute__((ext_vector_type(4)));
typedef float f32x16 __attribute__((ext_vector_type(16)));
typedef short bf16x8 __attribute__((ext_vector_type(8)));
typedef short s16x4 __attribute__((ext_vector_type(4)));
typedef unsigned u32x2 __attribute__((ext_vector_type(2)));
typedef unsigned u32x4 __attribute__((ext_vector_type(4)));

#ifndef MK_COOP
#define MK_COOP 1
#endif

constexpr int NB = 16, SEQ = 2048, NMETA = 16, L = SEQ + NMETA, D = 1024, M = NB * L;
constexpr int DFF = 2816, NH = 16, NZ = 3072;
constexpr float EPS = 1e-6f;
constexpr float QSCALE = 0.10206207261596577f * 1.4426950408889634f;
constexpr int NPHASE = 18;

constexpr size_t MiB = (size_t)1 << 20;
constexpr size_t WS_COS = 0, WS_SIN = 256 * 1024, WS_SS = 1 * MiB, WS_HM = 4 * MiB, WS_KR = 5 * MiB, WS_W = 8 * MiB, W_LAYER = 32 * MiB;
constexpr size_t W_IN = 0, W_UQ = 6 * MiB, W_UKV = 7 * MiB, W_C = 8 * MiB, W_PB = 9 * MiB, W_O = 11 * MiB, W_GU = 13 * MiB, W_D = 24 * MiB;
constexpr size_t WS_HB = 72 * MiB, WS_Y = WS_HB, WS_CQ = WS_HB + 33 * MiB, WS_CKV = WS_HB + 50 * MiB, WS_AO = WS_HB;
constexpr size_t WS_ZG = 137 * MiB, WS_BIG = 266 * MiB, WS_Q = WS_BIG, WS_KV = WS_BIG + 97 * MiB, WS_Z1 = WS_BIG, WS_MG = WS_BIG, WS_ACT = WS_BIG;
constexpr size_t WS_END = 492 * MiB;
static_assert(WS_SS + (size_t)M * 16 * 4 <= WS_HM && WS_KR + (size_t)M * 32 * 2 <= WS_W && WS_W + 2 * W_LAYER <= WS_HB, "ws map 1");
static_assert(WS_HB + (size_t)M * 1024 * 2 <= WS_ZG && WS_ZG + (size_t)M * 2048 * 2 <= WS_BIG && WS_Q + (size_t)M * 1536 * 2 <= WS_KV && WS_KV + (size_t)M * 2048 * 2 <= WS_END, "ws map 2");
static_assert(WS_ACT + (size_t)M * DFF * 2 <= WS_END && WS_CKV + (size_t)M * 128 * 2 <= WS_ZG && WS_CQ + (size_t)M * 256 * 2 <= WS_CKV && WS_Y + (size_t)M * 512 * 2 <= WS_CQ, "ws map 3");
static_assert(W_D + (size_t)1024 * DFF * 2 <= W_LAYER, "ws map 4");

struct Params {
    const float* in[18];
    float* out; unsigned char* ws;
    int ph_lo, ph_hi;
};

__device__ __forceinline__ const float* INP(const Params& p, int i) { asm volatile("" : "+s"(i)); return p.in[i]; }
__device__ __forceinline__ unsigned pk2(float lo, float hi) {
    typedef float f2_t __attribute__((ext_vector_type(2))); typedef __bf16 b2_t __attribute__((ext_vector_type(2)));
    f2_t v = {lo, hi}; b2_t b = __builtin_convertvector(v, b2_t); return __builtin_bit_cast(unsigned, b);
}
__device__ __forceinline__ float bflo(unsigned w) { return __uint_as_float(w << 16); }
__device__ __forceinline__ float bfhi(unsigned w) { return __uint_as_float(w & 0xffff0000u); }
__device__ __forceinline__ float bf1(bf16 x) { return __uint_as_float((unsigned)x << 16); }
__device__ __forceinline__ float wave_sum(float v) {
#pragma unroll
    for (int o = 1; o < 64; o <<= 1) v += __shfl_xor(v, o);
    return v;
}
__device__ __forceinline__ float sigmoidf_(float x) { return __builtin_amdgcn_rcpf(1.0f + __builtin_amdgcn_exp2f(-1.4426950408889634f * x)); }
__device__ __forceinline__ float row_rstd(const float* ss, int row) {
    const f32x4* p = (const f32x4*)(ss + (size_t)row * 16); const f32x4 a = p[0], b = p[1], c = p[2], d = p[3];
    const float s = ((a.x + a.y) + (a.z + a.w)) + ((b.x + b.y) + (b.z + b.w)) + ((c.x + c.y) + (c.z + c.w)) + ((d.x + d.y) + (d.z + d.w));
    return rsqrtf(s * (1.0f / 1024.0f) + EPS);
}

namespace pg8 {
#define EPI_ROW(ai, m) (u.pm * 256 + (ai) * 128 + wr * 64 + (m) * 16 + fr)
#define EPI_COL(bj, n) (u.pn * 256 + (bj) * 128 + wc * 32 + (n) * 16 + 4 * fq)
#define EPI_LOOP_ROWS _Pragma("unroll") for (int ai = 0; ai < 2; ++ai) _Pragma("unroll") for (int m = 0; m < 4; ++m)
#define EPI_LOOP_COLS _Pragma("unroll") for (int bj = 0; bj < 2; ++bj) _Pragma("unroll") for (int n = 0; n < 2; ++n)
typedef unsigned u32x2e __attribute__((ext_vector_type(2)));

struct EpiZ {
    static constexpr bool PERM = false, AFTER_DRAIN = false;
    const float* ss; bf16_t* z1; bf16_t* zg;
    __device__ __forceinline__ void operator()(const f32x4 (&acc)[2][2][4][2], const Unit& u, int wr, int wc, int fr, int fq) const {
        const bool gate = u.pn >= 4;
        EPI_LOOP_ROWS { const int row = EPI_ROW(ai, m); const float rs = row_rstd(ss, row);
            EPI_LOOP_COLS { const int col = EPI_COL(bj, n); f32x4 v = acc[ai][bj][m][n] * rs; u32x2e w;
                if (gate) { w.x = pk2(sigmoidf_(v[0]), sigmoidf_(v[1])); w.y = pk2(sigmoidf_(v[2]), sigmoidf_(v[3])); *(u32x2e*)(zg + (size_t)row * 2048 + (col - 1024)) = w; }
                else { w.x = pk2(v[0], v[1]); w.y = pk2(v[2], v[3]); *(u32x2e*)(z1 + (size_t)row * 1024 + col) = w; } } }
    }
};
struct EpiBf {
    static constexpr bool PERM = false, AFTER_DRAIN = false;
    bf16_t* o; int ldc;
    __device__ __forceinline__ void operator()(const f32x4 (&acc)[2][2][4][2], const Unit& u, int wr, int wc, int fr, int fq) const {
        EPI_LOOP_ROWS { const int row = EPI_ROW(ai, m);
            EPI_LOOP_COLS { const int col = EPI_COL(bj, n); const f32x4 v = acc[ai][bj][m][n]; u32x2e w; w.x = pk2(v[0], v[1]); w.y = pk2(v[2], v[3]); *(u32x2e*)(o + (size_t)row * ldc + col) = w; } }
    }
};
struct EpiQ {
    static constexpr bool PERM = false, AFTER_DRAIN = false;
    bf16_t* q; const float* cs; const float* sn;
    __device__ __forceinline__ void operator()(const f32x4 (&acc)[2][2][4][2], const Unit& u, int wr, int wc, int fr, int fq) const {
        const bool rope = u.pn >= 4;
        EPI_LOOP_ROWS { const int row = EPI_ROW(ai, m); const int t = row % L;
            f32x4 c4 = {1.f, 1.f, 1.f, 1.f}, s4 = {0.f, 0.f, 0.f, 0.f};
            if (rope) { c4 = *(const f32x4*)(cs + t * 16 + 4 * fq); s4 = *(const f32x4*)(sn + t * 16 + 4 * fq); }
#pragma unroll
            for (int bj = 0; bj < 2; ++bj) { const f32x4 x1 = acc[ai][bj][m][0], x2 = acc[ai][bj][m][1]; f32x4 o1, o2;
                if (rope) { o1 = x1 * c4 - x2 * s4; o2 = x1 * s4 + x2 * c4; } else { o1 = x1; o2 = x2; }
                o1 = o1 * QSCALE; o2 = o2 * QSCALE; u32x2e w1, w2; w1.x = pk2(o1[0], o1[1]); w1.y = pk2(o1[2], o1[3]); w2.x = pk2(o2[0], o2[1]); w2.y = pk2(o2[2], o2[3]);
                *(u32x2e*)(q + (size_t)row * 1536 + EPI_COL(bj, 0)) = w1; *(u32x2e*)(q + (size_t)row * 1536 + EPI_COL(bj, 1)) = w2; } }
    }
};
struct EpiTA {
    static constexpr bool PERM = false, AFTER_DRAIN = false;
    bf16_t* zg;
    __device__ __forceinline__ void operator()(const f32x4 (&acc)[2][2][4][2], const Unit& u, int wr, int wc, int fr, int fq) const {
        EPI_LOOP_ROWS { const int row = EPI_ROW(ai, m);
            EPI_LOOP_COLS { const int col = EPI_COL(bj, n); u32x2e* p = (u32x2e*)(zg + (size_t)row * 2048 + col); const u32x2e g = *p; const f32x4 v = acc[ai][bj][m][n];
                u32x2e w; w.x = pk2(bflo(g.x) * v[0], bfhi(g.x) * v[1]); w.y = pk2(bflo(g.y) * v[2], bfhi(g.y) * v[3]); *p = w; } }
    }
};
struct EpiMG {
    static constexpr bool PERM = false, AFTER_DRAIN = false;
    const bf16_t* zg; bf16_t* mg;
    __device__ __forceinline__ void operator()(const f32x4 (&acc)[2][2][4][2], const Unit& u, int wr, int wc, int fr, int fq) const {
        EPI_LOOP_ROWS { const int row = EPI_ROW(ai, m);
            EPI_LOOP_COLS { const int col = EPI_COL(bj, n); const u32x2e ta = *(const u32x2e*)(zg + (size_t)row * 2048 + col), gb = *(const u32x2e*)(zg + (size_t)row * 2048 + 1024 + col);
                const f32x4 v = acc[ai][bj][m][n]; u32x2e w;
                w.x = pk2(bflo(ta.x) + bflo(gb.x) * v[0], bfhi(ta.x) + bfhi(gb.x) * v[1]); w.y = pk2(bflo(ta.y) + bflo(gb.y) * v[2], bfhi(ta.y) + bfhi(gb.y) * v[3]);
                *(u32x2e*)(mg + (size_t)row * 1024 + col) = w; } }
    }
};
struct EpiRes {
    static constexpr bool PERM = false, AFTER_DRAIN = false;
    const float* x; const float* meta; bool first;
    float* out; float* hm; bf16_t* hb; float* ss;
    __device__ __forceinline__ void operator()(const f32x4 (&acc)[2][2][4][2], const Unit& u, int wr, int wc, int fr, int fq) const {
        EPI_LOOP_ROWS { const int row = EPI_ROW(ai, m); const int b = row / L, t = row - b * L;
            float* po = t < NMETA ? hm + (size_t)(b * NMETA + t) * D : out + ((size_t)b * SEQ + (t - NMETA)) * D;
            const float* pi = first ? (t < NMETA ? meta + (size_t)t * D : x + ((size_t)b * SEQ + (t - NMETA)) * D) : po;
            float s = 0.f;
            EPI_LOOP_COLS { const int col = EPI_COL(bj, n); const f32x4 v = *(const f32x4*)(pi + col) + acc[ai][bj][m][n];
                *(f32x4*)(po + col) = v; u32x2e w; w.x = pk2(v[0], v[1]); w.y = pk2(v[2], v[3]); *(u32x2e*)(hb + (size_t)row * 1024 + col) = w;
                s += (v[0] * v[0] + v[1] * v[1]) + (v[2] * v[2] + v[3] * v[3]); }
            s += __shfl_xor(s, 16); s += __shfl_xor(s, 32);
            if (fq == 0) ss[(size_t)row * 16 + u.pn * 4 + wc] = s; }
    }
};
struct EpiSw {
    static constexpr bool PERM = false, AFTER_DRAIN = false;
    const float* ss; bf16_t* act;
    __device__ __forceinline__ void operator()(const f32x4 (&acc)[2][2][4][2], const Unit& u, int wr, int wc, int fr, int fq) const {
        EPI_LOOP_ROWS { const int row = EPI_ROW(ai, m); const float rs = row_rstd(ss, row);
#pragma unroll
            for (int bj = 0; bj < 2; ++bj) { const f32x4 g = acc[ai][bj][m][0] * rs, up = acc[ai][bj][m][1] * rs; f32x4 a;
#pragma unroll
                for (int j = 0; j < 4; ++j) a[j] = g[j] * sigmoidf_(g[j]) * up[j];
                const int oc = (u.pn * 256 + bj * 128 + wc * 32) / 2 + 4 * fq; u32x2e w; w.x = pk2(a[0], a[1]); w.y = pk2(a[2], a[3]);
                *(u32x2e*)(act + (size_t)row * DFF + oc) = w; } }
    }
};
}
__device__ __forceinline__ void tr_item(const float* sp, int ldsrc, const float* kscale, int k0, bf16* dst_n0, int K, LAS float* scr, int lane) {
#pragma unroll 8
    for (int i = 0; i < 32; ++i) { const int kk = 2 * i + (lane >> 5); float v = sp ? sp[(size_t)(k0 + kk) * ldsrc] : 0.f; if (kscale) v *= kscale[k0 + kk]; scr[kk * 33 + (lane & 31)] = v; }
    asm volatile("s_waitcnt lgkmcnt(0)" ::: "memory");
    const int c = lane & 7;
#pragma unroll
    for (int j = 0; j < 4; ++j) { const int n = (lane >> 3) + 8 * j; const LAS float* s = scr + (8 * c) * 33 + n;
        u32x4 o; o.x = pk2(s[0 * 33], s[1 * 33]); o.y = pk2(s[2 * 33], s[3 * 33]); o.z = pk2(s[4 * 33], s[5 * 33]); o.w = pk2(s[6 * 33], s[7 * 33]);
        *(u32x4*)(dst_n0 + (size_t)n * K + k0 + 8 * c) = o; }
    asm volatile("s_waitcnt lgkmcnt(0)" ::: "memory");
}

constexpr int I_IN = 16 * 96, I_UQ = 4 * 48, I_UKV = 2 * 64, I_PB = 16 * 32, I_O = 16 * 32, I_GU = 16 * 176, I_D = 44 * 32;
constexpr int I_LAYER = I_IN + I_UQ + I_UKV + I_PB + I_O + I_GU + I_D;

__device__ __forceinline__ void prologue(const Params& p, LAS unsigned char* lds) {
    int tid_ = threadIdx.x; asm volatile("" : "+v"(tid_));
    const int lane = tid_ & 63, wave = __builtin_amdgcn_readfirstlane(tid_ >> 6), gw = blockIdx.x * 8 + wave, NGW = gridDim.x * 8; (void)wave;
    unsigned char* ws = p.ws;
    LAS float* scr = (LAS float*)(lds + wave * 16384);
    const int nl = lane & 31;
    for (int it = gw; it < 2 * I_LAYER; it += NGW) {
        const int l = it / I_LAYER; int r = it - l * I_LAYER;
        unsigned char* wl = ws + WS_W + (size_t)l * W_LAYER;
        if (r < I_IN) { const int nblk = 96, kb = r / nblk, nb = r % nblk, n = nb * 32 + nl;
            const float* src = INP(p, 3) + (size_t)l * 1024 * 2976; const float* sp = n < 928 ? src + n : (n < 1024 ? nullptr : src + (n - 96));
            tr_item(sp, 2976, INP(p, 2) + l * 1024, kb * 64, (bf16*)(wl + W_IN) + (size_t)nb * 32 * 1024, 1024, scr, lane); continue; } r -= I_IN;
        if (r < I_UQ) { const int nblk = 48, kb = r / nblk, nb = r % nblk, n = nb * 32 + nl;
            const float* src = INP(p, 8) + (size_t)l * 256 * 1536; const int sc = n < 1024 ? (n >> 6) * 96 + (n & 63) : ((n - 1024) >> 5) * 96 + 64 + (n & 31);
            tr_item(src + sc, 1536, nullptr, kb * 64, (bf16*)(wl + W_UQ) + (size_t)nb * 32 * 256, 256, scr, lane); continue; } r -= I_UQ;
        if (r < I_UKV) { const int nblk = 64, kb = r / nblk, nb = r % nblk, n = nb * 32 + nl;
            const float* src = INP(p, 9) + (size_t)l * 128 * 2048;
            tr_item(src + n, 2048, nullptr, kb * 64, (bf16*)(wl + W_UKV) + (size_t)nb * 32 * 128, 128, scr, lane); continue; } r -= I_UKV;
        if (r < I_PB) { const int nblk = 32, kb = r / nblk, nb = r % nblk, n = nb * 32 + nl;
            const float* src = INP(p, 11) + (size_t)l * 1024 * 1024;
            tr_item(src + n, 1024, nullptr, kb * 64, (bf16*)(wl + W_PB) + (size_t)nb * 32 * 1024, 1024, scr, lane); continue; } r -= I_PB;
        if (r < I_O) { const int nblk = 32, kb = r / nblk, nb = r % nblk, n = nb * 32 + nl;
            const float* src = INP(p, 12) + (size_t)l * 1024 * 1024;
            tr_item(src + n, 1024, nullptr, kb * 64, (bf16*)(wl + W_O) + (size_t)nb * 32 * 1024, 1024, scr, lane); continue; } r -= I_O;
        if (r < I_GU) { const int nblk = 176, kb = r / nblk, nb = r % nblk;
            const float* src = (nl < 16 ? INP(p, 14) : INP(p, 15)) + (size_t)l * 1024 * DFF + nb * 16 + (nl & 15);
            tr_item(src, DFF, INP(p, 13) + l * 1024, kb * 64, (bf16*)(wl + W_GU) + (size_t)nb * 32 * 1024, 1024, scr, lane); continue; } r -= I_GU;
        { const int nblk = 32, kb = r / nblk, nb = r % nblk, n = nb * 32 + nl;
            const float* src = INP(p, 16) + (size_t)l * DFF * 1024;
            tr_item(src + n, 1024, nullptr, kb * 64, (bf16*)(wl + W_D) + (size_t)nb * 32 * DFF, DFF, scr, lane); }
    }
    { const int gt = gw * 64 + lane, NT = NGW * 64;
      for (int idx = gt; idx < 2 * 65536; idx += NT) {
          const int l = idx >> 16, r = idx & 65535, n = r & 1023, kc = r >> 10, g = kc >> 4, i0 = (kc & 15) * 8;
          const float* pw = INP(p, 4) + (size_t)l * 4 * 128 * 128 + (size_t)g * 128 * 128 + (size_t)i0 * 128;
          const float* psc = INP(p, 5) + l * 512 + g * 128;
          const float* wpa = INP(p, 10) + (size_t)l * 512 * 1024 + (size_t)g * 128 * 1024 + n;
          float a[8] = {0.f, 0.f, 0.f, 0.f, 0.f, 0.f, 0.f, 0.f};
          for (int j = 0; j < 128; ++j) { const float w = psc[j] * wpa[(size_t)j * 1024];
#pragma unroll
              for (int e = 0; e < 8; ++e) a[e] += pw[e * 128 + j] * w; }
          u32x4 o; o.x = pk2(a[0], a[1]); o.y = pk2(a[2], a[3]); o.z = pk2(a[4], a[5]); o.w = pk2(a[6], a[7]);
          *(u32x4*)((bf16*)(ws + WS_W + (size_t)l * W_LAYER + W_C) + (size_t)n * 512 + kc * 8) = o; }
      float* cs = (float*)(ws + WS_COS); float* sn = (float*)(ws + WS_SIN);
      for (int idx = gt; idx < L * 16; idx += NT) { const int t = idx >> 4, i = idx & 15;
          const float inv = 1.0f / powf(10000.0f, (float)(2 * i) / 32.0f); const float ang = (float)t * inv;
          const double a = (double)ang; const double k = rint(a * 0.15915494309189535); const double rr = a - k * 6.283185307179586;
          const double r2 = rr * rr;
          double sv = rr * (1.0 + r2 * (-1.0/6 + r2 * (1.0/120 + r2 * (-1.0/5040 + r2 * (1.0/362880 + r2 * (-1.0/39916800 + r2 * (1.0/6227020800.0 + r2 * (-1.0/1307674368000.0 + r2 * (1.0/355687428096000.0)))))))));
          double cv = 1.0 + r2 * (-0.5 + r2 * (1.0/24 + r2 * (-1.0/720 + r2 * (1.0/40320 + r2 * (-1.0/3628800 + r2 * (1.0/479001600.0 + r2 * (-1.0/87178291200.0 + r2 * (1.0/20922789888000.0 + r2 * (-1.0/6402373705728000.0)))))))));
          cs[idx] = (float)cv; sn[idx] = (float)sv; }
    }
    { bf16* hb = (bf16*)(ws + WS_HB); float* ss = (float*)(ws + WS_SS);
      for (int m = gw; m < M; m += NGW) { const int b = m / L, t = m - b * L;
          const float* src = t < NMETA ? INP(p, 1) + (size_t)t * D : INP(p, 0) + ((size_t)b * SEQ + (t - NMETA)) * D;
          float s = 0.f;
#pragma unroll
          for (int j = 0; j < 4; ++j) { const f32x4 v = *(const f32x4*)(src + 256 * j + 4 * lane); s += (v[0] * v[0] + v[1] * v[1]) + (v[2] * v[2] + v[3] * v[3]);
              u32x2 w; w.x = pk2(v[0], v[1]); w.y = pk2(v[2], v[3]); *(u32x2*)(hb + (size_t)m * 1024 + 256 * j + 4 * lane) = w; }
          s = wave_sum(s);
          if (lane < 16) ss[(size_t)m * 16 + lane] = lane == 0 ? s : 0.f; }
    }
}

__device__ __forceinline__ void phase_elem(const Params& p, int l) {
    int tid_ = threadIdx.x; asm volatile("" : "+v"(tid_));
    const int lane = tid_ & 63, wave = __builtin_amdgcn_readfirstlane(tid_ >> 6), gw = blockIdx.x * 8 + wave, NGW = gridDim.x * 8; (void)wave;
    unsigned char* ws = p.ws;
    const bf16* Z1 = (const bf16*)(ws + WS_Z1); bf16* Y = (bf16*)(ws + WS_Y); bf16* CQ = (bf16*)(ws + WS_CQ); bf16* CKV = (bf16*)(ws + WS_CKV); bf16* KR = (bf16*)(ws + WS_KR);
    const float* cs = (const float*)(ws + WS_COS); const float* sn = (const float*)(ws + WS_SIN);
    const float* qg = INP(p, 6) + l * 256; const float* kg = INP(p, 7) + l * 128;
    const f32x4 qg4 = *(const f32x4*)(qg + 4 * lane); const float kg0 = kg[2 * lane], kg1 = kg[2 * lane + 1];
    const int grp = lane >> 4, win = 2 << grp;
    for (int m = gw; m < M; m += NGW) { const int b = m / L, t = m - b * L; const bf16* z = Z1 + (size_t)m * 1024;
        { const u32x2 v = *(const u32x2*)(z + 512 + 4 * lane); const float a0 = bflo(v.x), a1 = bfhi(v.x), a2 = bflo(v.y), a3 = bfhi(v.y);
          const float s = wave_sum((a0 * a0 + a1 * a1) + (a2 * a2 + a3 * a3)); const float rs = rsqrtf(s * (1.0f / 256.0f) + EPS);
          u32x2 w; w.x = pk2(a0 * rs * qg4[0], a1 * rs * qg4[1]); w.y = pk2(a2 * rs * qg4[2], a3 * rs * qg4[3]); *(u32x2*)(CQ + (size_t)m * 256 + 4 * lane) = w; }
        { const unsigned v = *(const unsigned*)(z + 768 + 2 * lane); const float a0 = bflo(v), a1 = bfhi(v);
          const float s = wave_sum(a0 * a0 + a1 * a1); const float rs = rsqrtf(s * (1.0f / 128.0f) + EPS);
          *(unsigned*)(CKV + (size_t)m * 128 + 2 * lane) = pk2(a0 * rs * kg0, a1 * rs * kg1); }
        if (lane < 16) { const float x1 = bf1(z[896 + lane]), x2 = bf1(z[912 + lane]); const float c = cs[t * 16 + lane], s = sn[t * 16 + lane];
          KR[(size_t)m * 32 + lane] = (bf16)(pk2(x1 * c - x2 * s, 0.f) & 0xffffu); KR[(size_t)m * 32 + 16 + lane] = (bf16)(pk2(x1 * s + x2 * c, 0.f) & 0xffffu); }
        { const int cnt = (t + 1) < win ? (t + 1) : win; float sum[8], cur[8];
          { const u32x4 v = *(const u32x4*)(z + 8 * lane); cur[0] = bflo(v.x); cur[1] = bfhi(v.x); cur[2] = bflo(v.y); cur[3] = bfhi(v.y); cur[4] = bflo(v.z); cur[5] = bfhi(v.z); cur[6] = bflo(v.w); cur[7] = bfhi(v.w); }
#pragma unroll
          for (int e = 0; e < 8; ++e) sum[e] = cur[e];
          for (int j = 1; j < cnt; ++j) { const u32x4 v = *(const u32x4*)(z - (size_t)j * 1024 + 8 * lane);
              sum[0] += bflo(v.x); sum[1] += bfhi(v.x); sum[2] += bflo(v.y); sum[3] += bfhi(v.y); sum[4] += bflo(v.z); sum[5] += bfhi(v.z); sum[6] += bflo(v.w); sum[7] += bfhi(v.w); }
          const float ic = 1.0f / (float)cnt; u32x4 o;
          o.x = pk2(sum[0] * ic - cur[0], sum[1] * ic - cur[1]); o.y = pk2(sum[2] * ic - cur[2], sum[3] * ic - cur[3]);
          o.z = pk2(sum[4] * ic - cur[4], sum[5] * ic - cur[5]); o.w = pk2(sum[6] * ic - cur[6], sum[7] * ic - cur[7]);
          *(u32x4*)(Y + (size_t)m * 512 + 8 * lane) = o; }
    }
}

__device__ __forceinline__ void phase_final(const Params& p) {
    int tid_ = threadIdx.x; asm volatile("" : "+v"(tid_));
    const int lane = tid_ & 63, wave = __builtin_amdgcn_readfirstlane(tid_ >> 6), gw = blockIdx.x * 8 + wave, NGW = gridDim.x * 8; (void)wave;
    const float* ss = (const float*)(p.ws + WS_SS); const float* g = INP(p, 17);
    for (int r = gw; r < NB * SEQ; r += NGW) { const int b = r / SEQ, t = r - b * SEQ; const int m = b * L + NMETA + t;
        const float rs = row_rstd(ss, m); float* o = p.out + (size_t)r * D;
#pragma unroll
        for (int j = 0; j < 4; ++j) { const f32x4 v = *(const f32x4*)(o + 256 * j + 4 * lane), gg = *(const f32x4*)(g + 256 * j + 4 * lane); *(f32x4*)(o + 256 * j + 4 * lane) = v * rs * gg; } }
}

namespace att {
constexpr int KROW = 208, KBUF = 64 * KROW, VBUF = 8192, OFF_K = 0, OFF_V = 2 * KBUF, LDS_BYTES = 2 * KBUF + 2 * VBUF;
__device__ __forceinline__ int crow(int r, int hi) { return (r & 3) + 8 * (r >> 2) + 4 * hi; }
#define ATT_MFMA(a, b, c) __builtin_amdgcn_mfma_f32_32x32x16_bf16((a), (b), (c), 0, 0, 0)
typedef short v4i16_t __attribute__((ext_vector_type(4)));
__device__ __forceinline__ s16x4 vtr(const LAS unsigned char* p) { return __builtin_bit_cast(s16x4, __builtin_amdgcn_ds_read_tr16_b64_v4i16((LAS v4i16_t*)p)); }

__device__ __forceinline__ void attn_unit(LAS unsigned char* lds, const bf16* Q, const bf16* KV, const bf16* KR, bf16* AO, int b, int h, int qi) {
    int tid_ = threadIdx.x; asm volatile("" : "+v"(tid_));
    const int tid = tid_, lane = tid & 63, wid = tid >> 6, r32 = lane & 31, hi = lane >> 5;
    const int row0 = NMETA + 256 * (qi - 1), nt = 4 * qi + 1;
    const int qrow = row0 + 32 * wid + r32, qrc = qrow < 0 ? 0 : qrow;
    const size_t rb = (size_t)b * L;
    bf16x8 qf[6];
    { const bf16* qp = Q + (rb + qrc) * 1536;
#pragma unroll
      for (int d0 = 0; d0 < 4; ++d0) qf[d0] = *(const bf16x8*)(qp + h * 64 + 16 * d0 + 8 * hi);
#pragma unroll
      for (int d0 = 4; d0 < 6; ++d0) qf[d0] = *(const bf16x8*)(qp + 1024 + h * 32 + 16 * (d0 - 4) + 8 * hi); }
    const int lk = tid >> 3, lc = tid & 7, rk = (tid >> 2) & 63, rc = tid & 3;
    u32x4 pk_ = {0, 0, 0, 0}, pv_ = {0, 0, 0, 0}, pr_ = {0, 0, 0, 0};
#define ATT_GLOAD(kt) do { int kg = 64 * (kt) + lk; kg = kg > L - 1 ? L - 1 : kg; const bf16* kp = KV + (rb + kg) * 2048 + h * 128 + lc * 8; pk_ = *(const u32x4*)kp; pv_ = *(const u32x4*)(kp + 64); \
        if (tid < 256) { int kg2 = 64 * (kt) + rk; kg2 = kg2 > L - 1 ? L - 1 : kg2; pr_ = *(const u32x4*)(KR + (rb + kg2) * 32 + rc * 8); } } while (0)
#define ATT_LSTORE(bufi) do { *(LAS u32x4*)(lds + OFF_K + (bufi) * KBUF + lk * KROW + lc * 16) = pk_; *(LAS u32x4*)(lds + OFF_V + (bufi) * VBUF + (lc >> 2) * 4096 + lk * 64 + (lc & 3) * 16) = pv_; \
        if (tid < 256) *(LAS u32x4*)(lds + OFF_K + (bufi) * KBUF + rk * KROW + 128 + rc * 16) = pr_; } while (0)
    float mrun = -INFINITY, lrun = 0.f; f32x16 o0, o1;
#pragma unroll
    for (int i = 0; i < 16; ++i) { o0[i] = 0.f; o1[i] = 0.f; }
    ATT_GLOAD(0); ATT_LSTORE(0); __syncthreads();
    for (int kt = 0; kt < nt; ++kt) {
        const int buf = kt & 1;
        if (kt + 1 < nt) ATT_GLOAD(kt + 1);
        f32x16 p0, p1;
#pragma unroll
        for (int i = 0; i < 16; ++i) { p0[i] = 0.f; p1[i] = 0.f; }
        const LAS unsigned char* kb = lds + OFF_K + buf * KBUF + r32 * KROW + hi * 16;
#pragma unroll
        for (int d0 = 0; d0 < 6; ++d0) { const bf16x8 a0 = *(const LAS bf16x8*)(kb + d0 * 32), a1 = *(const LAS bf16x8*)(kb + 32 * KROW + d0 * 32);
            p0 = ATT_MFMA(a0, qf[d0], p0); p1 = ATT_MFMA(a1, qf[d0], p1); }
        if (64 * kt + 63 > row0 + 32 * wid) {
#pragma unroll
            for (int i = 0; i < 16; ++i) { const int key = 64 * kt + crow(i, hi); if (key > qrc) p0[i] = -INFINITY; if (key + 32 > qrc) p1[i] = -INFINITY; }
        }
        float mx = fmaxf(p0[0], p1[0]);
#pragma unroll
        for (int i = 1; i < 16; ++i) mx = fmaxf(mx, fmaxf(p0[i], p1[i]));
        mx = fmaxf(mx, __shfl_xor(mx, 32));
        const float mnew = fmaxf(mrun, mx), alpha = __builtin_amdgcn_exp2f(mrun - mnew);
        float ls = 0.f;
#pragma unroll
        for (int i = 0; i < 16; ++i) { p0[i] = __builtin_amdgcn_exp2f(p0[i] - mnew); p1[i] = __builtin_amdgcn_exp2f(p1[i] - mnew); ls += p0[i] + p1[i]; }
        lrun = lrun * alpha + ls; mrun = mnew;
#pragma unroll
        for (int i = 0; i < 16; ++i) { o0[i] *= alpha; o1[i] *= alpha; }
        bf16x8 pa[4];
#pragma unroll
        for (int s = 0; s < 2; ++s) { u32x4 w;
            w.x = pk2(p0[8 * s + 0], p0[8 * s + 1]); w.y = pk2(p0[8 * s + 2], p0[8 * s + 3]); w.z = pk2(p0[8 * s + 4], p0[8 * s + 5]); w.w = pk2(p0[8 * s + 6], p0[8 * s + 7]); pa[s] = __builtin_bit_cast(bf16x8, w);
            w.x = pk2(p1[8 * s + 0], p1[8 * s + 1]); w.y = pk2(p1[8 * s + 2], p1[8 * s + 3]); w.z = pk2(p1[8 * s + 4], p1[8 * s + 5]); w.w = pk2(p1[8 * s + 6], p1[8 * s + 7]); pa[2 + s] = __builtin_bit_cast(bf16x8, w); }
        const LAS unsigned char* vb = lds + OFF_V + buf * VBUF + (4 * hi + ((lane & 15) >> 2)) * 64 + ((lane >> 4) & 1) * 32 + (lane & 3) * 8;
#pragma unroll
        for (int ks = 0; ks < 4; ++ks) {
            const s16x4 l0 = vtr(vb + ks * 1024), h0 = vtr(vb + ks * 1024 + 512), l1 = vtr(vb + 4096 + ks * 1024), h1 = vtr(vb + 4096 + ks * 1024 + 512);
            const bf16x8 v0 = {l0[0], l0[1], l0[2], l0[3], h0[0], h0[1], h0[2], h0[3]}, v1 = {l1[0], l1[1], l1[2], l1[3], h1[0], h1[1], h1[2], h1[3]};
            o0 = ATT_MFMA(v0, pa[ks], o0); o1 = ATT_MFMA(v1, pa[ks], o1); }
        if (kt + 1 < nt) ATT_LSTORE(buf ^ 1);
        __syncthreads();
    }
    const float lt = lrun + __shfl_xor(lrun, 32), inv = 1.0f / lt;
    if (qrow >= 0) { bf16* op = AO + (rb + qrow) * 1024 + h * 64;
#pragma unroll
        for (int g = 0; g < 4; ++g) { u32x2 w0, w1;
            w0.x = pk2(o0[4 * g] * inv, o0[4 * g + 1] * inv); w0.y = pk2(o0[4 * g + 2] * inv, o0[4 * g + 3] * inv);
            w1.x = pk2(o1[4 * g] * inv, o1[4 * g + 1] * inv); w1.y = pk2(o1[4 * g + 2] * inv, o1[4 * g + 3] * inv);
            *(u32x2*)(op + 8 * g + 4 * hi) = w0; *(u32x2*)(op + 32 + 8 * g + 4 * hi) = w1; } }
#undef ATT_GLOAD
#undef ATT_LSTORE
}
}

constexpr int LDS_BYTES = 131072 + 1024;
__global__ void __launch_bounds__(512, 2) mk_fwd(Params p) {
    extern __shared__ __attribute__((aligned(16))) unsigned char lds_raw[];
    LAS unsigned char* lds = (LAS unsigned char*)lds_raw;
    const int G = gridDim.x;
    unsigned char* ws = p.ws;
    const int lo = p.ph_lo, hi = p.ph_hi;
#define IN(k) (lo <= (k) && (k) < hi)
#define SEAM(k) do { if (IN(k) && IN((k) + 1)) { cg::this_grid().sync(); } } while (0)
    bf16* HB = (bf16*)(ws + WS_HB); float* SS = (float*)(ws + WS_SS); bf16* ZG = (bf16*)(ws + WS_ZG);

    if (IN(0)) { prologue(p, lds); }
    SEAM(0);
    for (int l = 0; l < 2; ++l) {
        const int pb = 1 + 8 * l;
        unsigned char* wl = ws + WS_W + (size_t)l * W_LAYER;
        if (IN(pb + 0)) {
            pg8::Gemm g{HB, (const bf16*)(wl + W_IN), M, NZ, 1024}; pg8::StaticOrder S; S.init(M, NZ, G, (int)blockIdx.x);
            pg8::EpiZ E{SS, (bf16*)(ws + WS_Z1), ZG};
            pg8::gemm_phase<pg8::EpiZ, pg8::StaticOrder, true, true>(lds, g, S, E);
        }
        SEAM(pb + 0);
        if (IN(pb + 1)) { phase_elem(p, l); }
        SEAM(pb + 1);
        if (IN(pb + 2)) {
            { pg8::Gemm g{(const bf16*)(ws + WS_CQ), (const bf16*)(wl + W_UQ), M, 1536, 256}; pg8::StaticOrder S; S.init(M, 1536, G, (int)blockIdx.x);
              pg8::EpiQ E{(bf16*)(ws + WS_Q), (const float*)(ws + WS_COS), (const float*)(ws + WS_SIN)};
              pg8::gemm_phase<pg8::EpiQ, pg8::StaticOrder, true, true>(lds, g, S, E); }
            { pg8::Gemm g{(const bf16*)(ws + WS_CKV), (const bf16*)(wl + W_UKV), M, 2048, 128}; pg8::StaticOrder S; S.init(M, 2048, G, (int)blockIdx.x);
              pg8::EpiBf E{(bf16*)(ws + WS_KV), 2048};
              pg8::gemm_phase<pg8::EpiBf, pg8::StaticOrder, true, true>(lds, g, S, E); }
            { pg8::Gemm g{(const bf16*)(ws + WS_Y), (const bf16*)(wl + W_C), M, 1024, 512}; pg8::StaticOrder S; S.init(M, 1024, G, (int)blockIdx.x);
              pg8::EpiTA E{ZG};
              pg8::gemm_phase<pg8::EpiTA, pg8::StaticOrder, true, true>(lds, g, S, E); }
        }
        SEAM(pb + 2);
        if (IN(pb + 3)) {
            for (int bh = blockIdx.x; bh < NB * NH; bh += G)
                for (int qi = 8; qi >= 0; --qi)
                    att::attn_unit(lds, (const bf16*)(ws + WS_Q), (const bf16*)(ws + WS_KV), (const bf16*)(ws + WS_KR), (bf16*)(ws + WS_AO), bh / NH, bh % NH, qi);
        }
        SEAM(pb + 3);
        if (IN(pb + 4)) {
            pg8::Gemm g{(const bf16*)(ws + WS_AO), (const bf16*)(wl + W_PB), M, 1024, 1024}; pg8::StaticOrder S; S.init(M, 1024, G, (int)blockIdx.x);
            pg8::EpiMG E{ZG, (bf16*)(ws + WS_MG)};
            pg8::gemm_phase<pg8::EpiMG, pg8::StaticOrder, true, true>(lds, g, S, E);
        }
        SEAM(pb + 4);
        if (IN(pb + 5)) {
            pg8::Gemm g{(const bf16*)(ws + WS_MG), (const bf16*)(wl + W_O), M, 1024, 1024}; pg8::StaticOrder S; S.init(M, 1024, G, (int)blockIdx.x);
            pg8::EpiRes E{INP(p, 0), INP(p, 1), l == 0, p.out, (float*)(ws + WS_HM), HB, SS};
            pg8::gemm_phase<pg8::EpiRes, pg8::StaticOrder, true, true>(lds, g, S, E);
        }
        SEAM(pb + 5);
        if (IN(pb + 6)) {
            pg8::Gemm g{HB, (const bf16*)(wl + W_GU), M, 2 * DFF, 1024}; pg8::StaticOrder S; S.init(M, 2 * DFF, G, (int)blockIdx.x);
            pg8::EpiSw E{SS, (bf16*)(ws + WS_ACT)};
            pg8::gemm_phase<pg8::EpiSw, pg8::StaticOrder, true, true>(lds, g, S, E);
        }
        SEAM(pb + 6);
        if (IN(pb + 7)) {
            pg8::Gemm g{(const bf16*)(ws + WS_ACT), (const bf16*)(wl + W_D), M, 1024, DFF}; pg8::StaticOrder S; S.init(M, 1024, G, (int)blockIdx.x);
            pg8::EpiRes E{INP(p, 0), INP(p, 1), false, p.out, (float*)(ws + WS_HM), HB, SS};
            pg8::gemm_phase<pg8::EpiRes, pg8::StaticOrder, true, true>(lds, g, S, E);
        }
        SEAM(pb + 7);
    }
    if (IN(17)) { phase_final(p); }
#undef IN
#undef SEAM
}

extern "C" void kernel_launch(void* const* d_in, const int* in_sizes, int n_in, void* d_out, int out_size, void* d_ws, size_t ws_size, hipStream_t stream) {
    static int grid = 0;
    if (grid == 0) {
        if (n_in != 18 || out_size != NB * SEQ * D || ws_size < WS_END) { fprintf(stderr, "kernel_launch: unexpected shapes (n_in %d out %d ws %zu need %zu)\n", n_in, out_size, ws_size, (size_t)WS_END); grid = -1; return; }
        int dev = 0, cus = 0, per_cu = 0;
        hipGetDevice(&dev); hipDeviceGetAttribute(&cus, hipDeviceAttributeMultiprocessorCount, dev);
        if (hipFuncSetAttribute((const void*)mk_fwd, hipFuncAttributeMaxDynamicSharedMemorySize, LDS_BYTES) != hipSuccess) { fprintf(stderr, "kernel_launch: hipFuncSetAttribute failed\n"); grid = -1; return; }
        if (hipOccupancyMaxActiveBlocksPerMultiprocessor(&per_cu, (const void*)mk_fwd, 512, LDS_BYTES) != hipSuccess || per_cu < 1) { fprintf(stderr, "kernel_launch: occupancy query says %d\n", per_cu); per_cu = 1; }
        (void)hipGetLastError();
        grid = cus;
    }
    if (grid < 0) return;
    Params p{};
    for (int i = 0; i < 18; ++i) p.in[i] = (const float*)d_in[i];
    p.out = (float*)d_out; p.ws = (unsigned char*)d_ws;
#if MK_COOP
    p.ph_lo = 0; p.ph_hi = NPHASE;
    void* args[] = {&p};
    hipError_t e = hipLaunchCooperativeKernel((const void*)mk_fwd, dim3(grid), dim3(512), args, LDS_BYTES, stream);
    if (e != hipSuccess) fprintf(stderr, "kernel_launch: cooperative launch failed: %s (grid %d)\n", hipGetErrorString(e), grid);
#else
    for (int k = 0; k < NPHASE; ++k) { p.ph_lo = k; p.ph_hi = k + 1; hipLaunchKernelGGL(mk_fwd, dim3(grid), dim3(512), LDS_BYTES, stream, p); }
#endif
}
```

```cpp
#include <hip/hip_runtime.h>
#include <hip/hip_cooperative_groups.h>
#include <cstdio>
#include <cstdint>
#include <cmath>
namespace cg = cooperative_groups;
namespace pg8 {
#define PG8_LAS __attribute__((address_space(3)))
typedef unsigned short bf16_t;
typedef short bf16x8 __attribute__((ext_vector_type(8)));
typedef float f32x4 __attribute__((ext_vector_type(4)));
typedef unsigned u32x4 __attribute__((ext_vector_type(4)));
constexpr int BM = 256, BK = 64, HALF = 128, HTB = HALF * BK * 2  , STAGE_BYTES = 8 * HTB, NXCD = 8, WGM = 8;

__host__ __device__ __forceinline__ int lds_byte(int r, int c) { const int st = (r >> 4) * 2 + (c >> 5), rr = r & 15, cc = c & 31, ob = rr * 64 + cc * 2; return st * 1024 + (ob ^ (((ob >> 9) & 1) << 5)); }
__host__ __device__ __forceinline__ void stage_rc(int b, int& R, int& C) { const int st = b / 1024, sb = b % 1024, swz = sb ^ (((sb >> 9) & 1) << 5); R = (st >> 1) * 16 + swz / 64; C = (st & 1) * 32 + (swz % 64) / 2; }
__host__ __device__ __forceinline__ int perm32(int rho) { const int n = rho >> 4, i = rho & 15; return 8 * (i >> 2) + 4 * n + (i & 3); }

struct Unit { int pm, pn; };
struct Gemm { const bf16_t* A; const bf16_t* Bt; int M, N, K; };

struct StaticOrder {
    int nM, nN, nwg, G, c;
    __host__ __device__ void init(int M, int N, int G_, int c_) { nM = M / BM; nN = N / BM; nwg = nM * nN; G = G_; c = c_; }
    __host__ __device__ bool next(int i, Unit& u) const {
        const long L = (long)i * G + c; if (L >= nwg) return false;
        int wgid = (int)L; { const int q = nwg / NXCD, r = nwg % NXCD, xcd = wgid % NXCD, off = wgid / NXCD; wgid = (xcd < r ? xcd * (q + 1) : r * (q + 1) + (xcd - r) * q) + off; }
        const int nig = WGM * nN, gid = wgid / nig, fm = gid * WGM, gsz = (nM - fm) < WGM ? (nM - fm) : WGM;
        u.pm = fm + ((wgid % nig) % gsz); u.pn = (wgid % nig) / gsz; return true;
    }
    __device__ __forceinline__ void a_ready(const Unit&) const {}
    __device__ __forceinline__ void done(const Unit&) const {}
};

template <class Epi, class Sched, bool ALIGN_EPI = false, bool SP2 = false>
__device__ __forceinline__ void gemm_phase(PG8_LAS unsigned char* lds, const Gemm g, const Sched& S, const Epi& E) {
    int tid_ = threadIdx.x; asm volatile("" : "+v"(tid_));
    const int tid = tid_, wid = __builtin_amdgcn_readfirstlane(tid >> 6), lane = tid & 63, wr = wid >> 2, wc = wid & 3, fr = lane & 15, fq = lane >> 4;
    int K_ = g.K; asm volatile("" : "+s"(K_));
    const int K = K_, nt = K / BK;
    unsigned voffA[2], voffB[2];
#pragma unroll
    for (int i = 0; i < 2; ++i) { int R, C; stage_rc(tid * 16 + i * 8192, R, C); const int Rb = Epi::PERM ? ((R & ~31) + perm32(R & 31)) : R;
        voffA[i] = (unsigned)(R * K + C) * 2u; voffB[i] = (unsigned)(Rb * K + C) * 2u; }
    const size_t kstep = (size_t)(BK * 2);
    const size_t hstep = (size_t)HALF * K * 2;
    const size_t tstep = 2 * hstep;
    const unsigned ldsw = (unsigned)wid * 1024u;
    const int aoff = lds_byte(wr * 64 + fr, fq * 8), boff = lds_byte(wc * 32 + fr, fq * 8);
#define PG8_SA(b, h) (((b) * 2 + (h)) * HTB)
#define PG8_SB(b, h) ((4 + (b) * 2 + (h)) * HTB)
#define PG8_STAGE(bufoff, gbase, voff) do { _Pragma("unroll") for (int _i = 0; _i < 2; ++_i) \
        __builtin_amdgcn_global_load_lds((const unsigned*)((const char*)(gbase) + (voff)[_i]), (PG8_LAS unsigned*)(lds + (bufoff) + ldsw + _i * 8192), 16, 0, 0); } while (0)
#define PG8_LDA(dst, b, h) do { _Pragma("unroll") for (int m = 0; m < 4; ++m) _Pragma("unroll") for (int k = 0; k < 2; ++k) dst[m][k] = *(const PG8_LAS bf16x8*)(lds + PG8_SA(b, h) + aoff + m * 2048 + k * 1024); } while (0)
#define PG8_LDB(dst, b, h) do { _Pragma("unroll") for (int n = 0; n < 2; ++n) _Pragma("unroll") for (int k = 0; k < 2; ++k) dst[n][k] = *(const PG8_LAS bf16x8*)(lds + PG8_SB(b, h) + boff + n * 2048 + k * 1024); } while (0)
#define PG8_MMA(ai, bj, At, Bt) do { __builtin_amdgcn_s_setprio(1); _Pragma("unroll") for (int m = 0; m < 4; ++m) _Pragma("unroll") for (int n = 0; n < 2; ++n) _Pragma("unroll") for (int k = 0; k < 2; ++k) \
        acc[ai][bj][m][n] = __builtin_amdgcn_mfma_f32_16x16x32_bf16(Bt[n][k], At[m][k], acc[ai][bj][m][n], 0, 0, 0); __builtin_amdgcn_s_setprio(0); } while (0)
#define PG8_WAIT_V(n) asm volatile("s_waitcnt vmcnt(" #n ")" ::: "memory")
#define PG8_WAIT_L(n) asm volatile("s_waitcnt lgkmcnt(" #n ")" ::: "memory")
#define PG8_BAR __builtin_amdgcn_s_barrier()
#define PG8_SCHED __builtin_amdgcn_sched_barrier(0)
    Unit cur, nxt; int ui = 0;
    if (!S.next(0, cur)) return;
    f32x4 acc[2][2][4][2];
#pragma unroll
    for (int a = 0; a < 2; ++a)
#pragma unroll
        for (int b = 0; b < 2; ++b)
#pragma unroll
            for (int m = 0; m < 4; ++m)
#pragma unroll
                for (int n = 0; n < 2; ++n) acc[a][b][m][n] = (f32x4){0.f, 0.f, 0.f, 0.f};
    bf16x8 At[4][2], B0[2][2], B1[2][2];
    const char* cA = (const char*)g.A + (size_t)cur.pm * tstep; const char* cB = (const char*)g.Bt + (size_t)cur.pn * tstep;
    S.a_ready(cur);
    if constexpr (SP2) {
        PG8_STAGE(PG8_SB(0, 0), cB, voffB); PG8_STAGE(PG8_SB(0, 1), cB + hstep, voffB); PG8_STAGE(PG8_SA(0, 0), cA, voffA); PG8_STAGE(PG8_SA(0, 1), cA + hstep, voffA);
        if (wr == 1) PG8_BAR;
        PG8_WAIT_V(2); PG8_BAR;
        PG8_STAGE(PG8_SB(1, 0), cB + kstep, voffB); PG8_STAGE(PG8_SA(1, 0), cA + kstep, voffA); PG8_STAGE(PG8_SB(1, 1), cB + hstep + kstep, voffB);
        PG8_WAIT_V(6); PG8_BAR;
    } else {
        PG8_STAGE(PG8_SB(0, 0), cB, voffB); PG8_STAGE(PG8_SA(0, 0), cA, voffA); PG8_STAGE(PG8_SB(0, 1), cB + hstep, voffB); PG8_STAGE(PG8_SA(0, 1), cA + hstep, voffA);
        if (wr == 1) PG8_BAR;
        PG8_WAIT_V(4); PG8_BAR;
        PG8_STAGE(PG8_SB(1, 0), cB + kstep, voffB); PG8_STAGE(PG8_SA(1, 0), cA + kstep, voffA); PG8_STAGE(PG8_SB(1, 1), cB + hstep + kstep, voffB);
        PG8_WAIT_V(6); PG8_BAR;
    }
    for (;;) {
        const bool has_next = S.next(ui + 1, nxt);
        const char* nA = has_next ? (const char*)g.A + (size_t)nxt.pm * tstep : cA; const char* nB = has_next ? (const char*)g.Bt + (size_t)nxt.pn * tstep : cB;
        for (int t = 0; t < nt; t += 2) {
            const bool last = (t == nt - 2);
            const char* a1 = cA + (size_t)(t + 1) * kstep;
            const char* a2 = last ? nA : cA + (size_t)(t + 2) * kstep; const char* b2 = last ? nB : cB + (size_t)(t + 2) * kstep;
            const char* a3 = a2 + kstep; const char* b3 = b2 + kstep;
            if (last && has_next) S.a_ready(nxt);
            if constexpr (SP2) {
            PG8_LDB(B0, 0, 0); PG8_LDB(B1, 0, 1); PG8_SCHED; PG8_LDA(At, 0, 0); PG8_STAGE(PG8_SA(1, 1), a1 + hstep, voffA);
            PG8_WAIT_V(8); PG8_WAIT_L(0); PG8_BAR; PG8_MMA(0, 0, At, B0); PG8_MMA(0, 1, At, B1); PG8_BAR; PG8_SCHED;
            PG8_LDA(At, 0, 1); PG8_STAGE(PG8_SB(0, 0), b2, voffB); PG8_STAGE(PG8_SB(0, 1), b2 + hstep, voffB); PG8_STAGE(PG8_SA(0, 0), a2, voffA);
            PG8_WAIT_V(8); PG8_WAIT_L(0); PG8_BAR; PG8_MMA(1, 0, At, B0); PG8_MMA(1, 1, At, B1); PG8_BAR; PG8_SCHED;
            PG8_LDB(B0, 1, 0); PG8_LDB(B1, 1, 1); PG8_SCHED; PG8_LDA(At, 1, 0); PG8_STAGE(PG8_SA(0, 1), a2 + hstep, voffA);
            PG8_WAIT_V(8); PG8_WAIT_L(0); PG8_BAR; PG8_MMA(0, 0, At, B0); PG8_MMA(0, 1, At, B1); PG8_BAR; PG8_SCHED;
            PG8_LDA(At, 1, 1); PG8_STAGE(PG8_SB(1, 0), b3, voffB); PG8_STAGE(PG8_SB(1, 1), b3 + hstep, voffB); PG8_STAGE(PG8_SA(1, 0), a3, voffA);
            PG8_WAIT_V(8); PG8_WAIT_L(0); PG8_BAR; PG8_MMA(1, 0, At, B0); PG8_MMA(1, 1, At, B1); PG8_BAR; PG8_SCHED;
            } else {
            PG8_LDB(B0, 0, 0); PG8_SCHED; PG8_LDA(At, 0, 0); PG8_STAGE(PG8_SA(1, 1), a1 + hstep, voffA);
            PG8_WAIT_L(8); PG8_BAR; PG8_WAIT_L(0); PG8_MMA(0, 0, At, B0); PG8_BAR; PG8_SCHED;
            PG8_LDB(B1, 0, 1); PG8_STAGE(PG8_SB(0, 0), b2, voffB);
            PG8_BAR; PG8_WAIT_L(0); PG8_MMA(0, 1, At, B1); PG8_BAR;
            PG8_LDA(At, 0, 1); PG8_STAGE(PG8_SA(0, 0), a2, voffA);
            PG8_BAR; PG8_WAIT_L(0); PG8_MMA(1, 0, At, B0); PG8_BAR; PG8_SCHED;
            PG8_STAGE(PG8_SB(0, 1), b2 + hstep, voffB);
            PG8_WAIT_V(6); PG8_BAR; PG8_MMA(1, 1, At, B1); PG8_BAR;
            PG8_LDB(B0, 1, 0); PG8_SCHED; PG8_LDA(At, 1, 0); PG8_STAGE(PG8_SA(0, 1), a2 + hstep, voffA);
            PG8_WAIT_L(8); PG8_BAR; PG8_WAIT_L(0); PG8_MMA(0, 0, At, B0); PG8_BAR; PG8_SCHED;
            PG8_LDB(B1, 1, 1); PG8_STAGE(PG8_SB(1, 0), b3, voffB);
            PG8_BAR; PG8_WAIT_L(0); PG8_MMA(0, 1, At, B1); PG8_BAR;
            PG8_LDA(At, 1, 1); PG8_STAGE(PG8_SA(1, 0), a3, voffA);
            PG8_BAR; PG8_WAIT_L(0); PG8_MMA(1, 0, At, B0); PG8_BAR; PG8_SCHED;
            PG8_STAGE(PG8_SB(1, 1), b3 + hstep, voffB);
            PG8_WAIT_V(6); PG8_BAR; PG8_MMA(1, 1, At, B1); PG8_BAR;
            }
        }
        if constexpr (ALIGN_EPI) { if (wr == 0) PG8_BAR; }
        if constexpr (!Epi::AFTER_DRAIN) { E(acc, cur, wr, wc, fr, fq); S.done(cur); }
        if (!has_next) break;
#pragma unroll
        for (int a = 0; a < 2; ++a)
#pragma unroll
            for (int b = 0; b < 2; ++b)
#pragma unroll
                for (int m = 0; m < 4; ++m)
#pragma unroll
                    for (int n = 0; n < 2; ++n) acc[a][b][m][n] = (f32x4){0.f, 0.f, 0.f, 0.f};
        cur = nxt; cA = nA; cB = nB; ++ui;
        if constexpr (ALIGN_EPI) { if (wr == 1) PG8_BAR; }
    }
    PG8_WAIT_V(0);
    if constexpr (!ALIGN_EPI) { if (wr == 0) PG8_BAR; }
    PG8_BAR;
    if constexpr (Epi::AFTER_DRAIN) { E.fused(acc, cur, wr, wc, fr, fq, lds, wid, lane); S.done(cur); }
#undef PG8_SA
#undef PG8_SB
#undef PG8_STAGE
#undef PG8_LDA
#undef PG8_LDB
#undef PG8_MMA
#undef PG8_WAIT_V
#undef PG8_WAIT_L
#undef PG8_BAR
#undef PG8_SCHED
}
}
#define LAS __attribute__((address_space(3)))
typedef unsigned short bf16;
typedef float f32x4 __attribute__((ext_vector_type(4)));
typedef float f32x16 __attribute__((ext_vector_type(16)));
typedef short bf16x8 __attribute__((ext_vector_type(8)));
typedef short s16x4 __attribute__((ext_vector_type(4)));
typedef unsigned u32x2 __attribute__((ext_vector_type(2)));
typedef unsigned u32x4 __attribute__((ext_vector_type(4)));

#ifndef MK_COOP
#define MK_COOP 1
#endif

constexpr int NB = 16, SEQ = 2048, NMETA = 16, L = SEQ + NMETA, D = 1024, M = NB * L;
constexpr int DFF = 2816, NH = 16, NZ = 3072;
constexpr float EPS = 1e-6f;
constexpr float QSCALE = 0.10206207261596577f * 1.4426950408889634f;
constexpr int NPHASE = 18;

constexpr size_t MiB = (size_t)1 << 20;
constexpr size_t WS_COS = 0, WS_SIN = 256 * 1024, WS_SS = 1 * MiB, WS_HM = 4 * MiB, WS_KR = 5 * MiB, WS_W = 8 * MiB, W_LAYER = 32 * MiB;
constexpr size_t W_IN = 0, W_UQ = 6 * MiB, W_UKV = 7 * MiB, W_C = 8 * MiB, W_PB = 9 * MiB, W_O = 11 * MiB, W_GU = 13 * MiB, W_D = 24 * MiB;
constexpr size_t WS_HB = 72 * MiB;
constexpr size_t OUT_Y = 0, OUT_CQ = 33 * MiB, OUT_CKV = 50 * MiB, OUT_AO = 0;
constexpr size_t WS_ZG = 137 * MiB, WS_BIG = 266 * MiB, WS_Q = WS_BIG, WS_KV = WS_BIG + 97 * MiB, WS_Z1 = WS_BIG, WS_MG = WS_BIG, WS_ACT = WS_BIG;
constexpr size_t WS_END = 492 * MiB;
static_assert(WS_SS + (size_t)M * 16 * 4 <= WS_HM && WS_KR + (size_t)M * 32 * 2 <= WS_W && WS_W + 2 * W_LAYER <= WS_HB, "ws map 1");
static_assert(WS_HB + (size_t)M * 1024 * 2 <= WS_ZG && WS_ZG + (size_t)M * 2048 * 2 <= WS_BIG && WS_Q + (size_t)M * 1536 * 2 <= WS_KV && WS_KV + (size_t)M * 2048 * 2 <= WS_END, "ws map 2");
static_assert(WS_ACT + (size_t)M * DFF * 2 <= WS_END && OUT_CKV + (size_t)M * 128 * 2 <= (size_t)128 * MiB && OUT_CQ + (size_t)M * 256 * 2 <= OUT_CKV && OUT_Y + (size_t)M * 512 * 2 <= OUT_CQ && OUT_AO + (size_t)M * 1024 * 2 <= (size_t)128 * MiB, "ws map 3");
static_assert(W_D + (size_t)1024 * DFF * 2 <= W_LAYER, "ws map 4");

struct Params {
    const float* in[18];
    float* out; unsigned char* ws;
    int ph_lo, ph_hi;
};

__device__ __forceinline__ const float* INP(const Params& p, int i) { asm volatile("" : "+s"(i)); return p.in[i]; }
__device__ __forceinline__ unsigned pk2(float lo, float hi) {
    typedef float f2_t __attribute__((ext_vector_type(2))); typedef __bf16 b2_t __attribute__((ext_vector_type(2)));
    f2_t v = {lo, hi}; b2_t b = __builtin_convertvector(v, b2_t); return __builtin_bit_cast(unsigned, b);
}
__device__ __forceinline__ float bflo(unsigned w) { return __uint_as_float(w << 16); }
__device__ __forceinline__ float bfhi(unsigned w) { return __uint_as_float(w & 0xffff0000u); }
__device__ __forceinline__ float bf1(bf16 x) { return __uint_as_float((unsigned)x << 16); }
__device__ __forceinline__ float wave_sum(float v) {
#pragma unroll
    for (int o = 1; o < 64; o <<= 1) v += __shfl_xor(v, o);
    return v;
}
__device__ __forceinline__ float sigmoidf_(float x) { return __builtin_amdgcn_rcpf(1.0f + __builtin_amdgcn_exp2f(-1.4426950408889634f * x)); }
__device__ __forceinline__ float row_rstd(const float* ss, int row) {
    const f32x4* p = (const f32x4*)(ss + (size_t)row * 16); const f32x4 a = p[0], b = p[1], c = p[2], d = p[3];
    const float s = ((a.x + a.y) + (a.z + a.w)) + ((b.x + b.y) + (b.z + b.w)) + ((c.x + c.y) + (c.z + c.w)) + ((d.x + d.y) + (d.z + d.w));
    return rsqrtf(s * (1.0f / 1024.0f) + EPS);
}

namespace pg8 {
#define EPI_ROW(ai, m) (u.pm * 256 + (ai) * 128 + wr * 64 + (m) * 16 + fr)
#define EPI_COL8(bj) (u.pn * 256 + (bj) * 128 + wc * 32 + 8 * fq)
#define EPI_LOOP_ROWS _Pragma("unroll") for (int ai = 0; ai < 2; ++ai) _Pragma("unroll") for (int m = 0; m < 4; ++m)
#define EPI_LOOP_BJ _Pragma("unroll") for (int bj = 0; bj < 2; ++bj)
typedef unsigned u32x2e __attribute__((ext_vector_type(2)));
__device__ __forceinline__ u32x4 pack8(const f32x4 a, const f32x4 b) { u32x4 w; w.x = pk2(a[0], a[1]); w.y = pk2(a[2], a[3]); w.z = pk2(b[0], b[1]); w.w = pk2(b[2], b[3]); return w; }
__device__ __forceinline__ f32x4 unlo(const u32x4 w) { return (f32x4){bflo(w.x), bfhi(w.x), bflo(w.y), bfhi(w.y)}; }
__device__ __forceinline__ f32x4 unhi(const u32x4 w) { return (f32x4){bflo(w.z), bfhi(w.z), bflo(w.w), bfhi(w.w)}; }
__device__ __forceinline__ f32x4 sig4(const f32x4 v) { return (f32x4){sigmoidf_(v[0]), sigmoidf_(v[1]), sigmoidf_(v[2]), sigmoidf_(v[3])}; }

struct EpiZ {
    static constexpr bool PERM = true, AFTER_DRAIN = false;
    const float* ss; bf16_t* z1; bf16_t* zg;
    __device__ __forceinline__ void operator()(const f32x4 (&acc)[2][2][4][2], const Unit& u, int wr, int wc, int fr, int fq) const {
        const bool gate = u.pn >= 4;
        EPI_LOOP_ROWS { const int row = EPI_ROW(ai, m); const float rs = row_rstd(ss, row);
            EPI_LOOP_BJ { const int col = EPI_COL8(bj); f32x4 v0 = acc[ai][bj][m][0] * rs, v1 = acc[ai][bj][m][1] * rs;
                if (gate) { *(u32x4*)(zg + (size_t)row * 2048 + (col - 1024)) = pack8(sig4(v0), sig4(v1)); }
                else { *(u32x4*)(z1 + (size_t)row * 1024 + col) = pack8(v0, v1); } } }
    }
};
struct EpiBf {
    static constexpr bool PERM = true, AFTER_DRAIN = false;
    bf16_t* o; int ldc;
    __device__ __forceinline__ void operator()(const f32x4 (&acc)[2][2][4][2], const Unit& u, int wr, int wc, int fr, int fq) const {
        EPI_LOOP_ROWS { const int row = EPI_ROW(ai, m);
            EPI_LOOP_BJ { *(u32x4*)(o + (size_t)row * ldc + EPI_COL8(bj)) = pack8(acc[ai][bj][m][0], acc[ai][bj][m][1]); } }
    }
};
struct EpiQ {
    static constexpr bool PERM = true, AFTER_DRAIN = false;
    bf16_t* q; const float* cs; const float* sn;
    __device__ __forceinline__ void operator()(const f32x4 (&acc)[2][2][4][2], const Unit& u, int wr, int wc, int fr, int fq) const {
        const bool rope = u.pn >= 4;
        EPI_LOOP_ROWS { const int row = EPI_ROW(ai, m); const int t = row % L;
            f32x4 c4 = {1.f, 1.f, 1.f, 1.f}, s4 = {0.f, 0.f, 0.f, 0.f};
            if (rope) { c4 = *(const f32x4*)(cs + t * 16 + 4 * fq); s4 = *(const f32x4*)(sn + t * 16 + 4 * fq); }
            EPI_LOOP_BJ { const f32x4 x1 = acc[ai][bj][m][0], x2 = acc[ai][bj][m][1]; f32x4 o1, o2;
                if (rope) { o1 = x1 * c4 - x2 * s4; o2 = x1 * s4 + x2 * c4; } else { o1 = x1; o2 = x2; }
                *(u32x4*)(q + (size_t)row * 1536 + EPI_COL8(bj)) = pack8(o1 * QSCALE, o2 * QSCALE); } }
    }
};
struct EpiTA {
    static constexpr bool PERM = true, AFTER_DRAIN = false;
    bf16_t* zg;
    __device__ __forceinline__ void operator()(const f32x4 (&acc)[2][2][4][2], const Unit& u, int wr, int wc, int fr, int fq) const {
        EPI_LOOP_ROWS { const int row = EPI_ROW(ai, m);
            EPI_LOOP_BJ { u32x4* p = (u32x4*)(zg + (size_t)row * 2048 + EPI_COL8(bj)); const u32x4 g = *p;
                *p = pack8(unlo(g) * acc[ai][bj][m][0], unhi(g) * acc[ai][bj][m][1]); } }
    }
};
struct EpiMG {
    static constexpr bool PERM = true, AFTER_DRAIN = false;
    const bf16_t* zg; bf16_t* mg;
    __device__ __forceinline__ void operator()(const f32x4 (&acc)[2][2][4][2], const Unit& u, int wr, int wc, int fr, int fq) const {
        EPI_LOOP_ROWS { const int row = EPI_ROW(ai, m);
            EPI_LOOP_BJ { const int col = EPI_COL8(bj); const u32x4 ta = *(const u32x4*)(zg + (size_t)row * 2048 + col), gb = *(const u32x4*)(zg + (size_t)row * 2048 + 1024 + col);
                *(u32x4*)(mg + (size_t)row * 1024 + col) = pack8(unlo(ta) + unlo(gb) * acc[ai][bj][m][0], unhi(ta) + unhi(gb) * acc[ai][bj][m][1]); } }
    }
};
struct EpiRes {
    static constexpr bool PERM = true, AFTER_DRAIN = false;
    const float* x; const float* meta; bool first;
    bf16_t* hb; float* ss;
    __device__ __forceinline__ void operator()(const f32x4 (&acc)[2][2][4][2], const Unit& u, int wr, int wc, int fr, int fq) const {
        EPI_LOOP_ROWS { const int row = EPI_ROW(ai, m); const int b = row / L, t = row - b * L;
            const float* pi = t < NMETA ? meta + (size_t)t * D : x + ((size_t)b * SEQ + (t - NMETA)) * D;
            float s = 0.f;
            EPI_LOOP_BJ { const int col = EPI_COL8(bj); u32x4* ph = (u32x4*)(hb + (size_t)row * 1024 + col); f32x4 v0, v1;
                if (first) { v0 = *(const f32x4*)(pi + col); v1 = *(const f32x4*)(pi + col + 4); } else { const u32x4 h = *ph; v0 = unlo(h); v1 = unhi(h); }
                v0 = v0 + acc[ai][bj][m][0]; v1 = v1 + acc[ai][bj][m][1]; *ph = pack8(v0, v1);
                s += ((v0[0] * v0[0] + v0[1] * v0[1]) + (v0[2] * v0[2] + v0[3] * v0[3])) + ((v1[0] * v1[0] + v1[1] * v1[1]) + (v1[2] * v1[2] + v1[3] * v1[3])); }
            s += __shfl_xor(s, 16); s += __shfl_xor(s, 32);
            if (fq == 0) ss[(size_t)row * 16 + u.pn * 4 + wc] = s; }
    }
};
struct EpiSw {
    static constexpr bool PERM = true, AFTER_DRAIN = false;
    const float* ss; bf16_t* act;
    __device__ __forceinline__ void operator()(const f32x4 (&acc)[2][2][4][2], const Unit& u, int wr, int wc, int fr, int fq) const {
        EPI_LOOP_ROWS { const int row = EPI_ROW(ai, m); const float rs = row_rstd(ss, row);
            EPI_LOOP_BJ { const f32x4 g = acc[ai][bj][m][0] * rs, up = acc[ai][bj][m][1] * rs; const f32x4 a = g * sig4(g) * up;
                u32x2e w; w.x = pk2(a[0], a[1]); w.y = pk2(a[2], a[3]);
                *(u32x2e*)(act + (size_t)row * DFF + (EPI_COL8(bj) >> 1)) = w; } }
    }
};
}
__device__ __forceinline__ void tr_item(const float* sp, int ldsrc, const float* kscale, int k0, bf16* dst_n0, int K, LAS float* scr, int lane) {
#pragma unroll 8
    for (int i = 0; i < 32; ++i) { const int kk = 2 * i + (lane >> 5); float v = sp ? sp[(size_t)(k0 + kk) * ldsrc] : 0.f; if (kscale) v *= kscale[k0 + kk]; scr[kk * 33 + (lane & 31)] = v; }
    asm volatile("s_waitcnt lgkmcnt(0)" ::: "memory");
    const int c = lane & 7;
#pragma unroll
    for (int j = 0; j < 4; ++j) { const int n = (lane >> 3) + 8 * j; const LAS float* s = scr + (8 * c) * 33 + n;
        u32x4 o; o.x = pk2(s[0 * 33], s[1 * 33]); o.y = pk2(s[2 * 33], s[3 * 33]); o.z = pk2(s[4 * 33], s[5 * 33]); o.w = pk2(s[6 * 33], s[7 * 33]);
        *(u32x4*)(dst_n0 + (size_t)n * K + k0 + 8 * c) = o; }
    asm volatile("s_waitcnt lgkmcnt(0)" ::: "memory");
}

constexpr int I_IN = 16 * 96, I_UQ = 4 * 48, I_UKV = 2 * 64, I_PB = 16 * 32, I_O = 16 * 32, I_GU = 16 * 176, I_D = 44 * 32;
constexpr int I_LAYER = I_IN + I_UQ + I_UKV + I_PB + I_O + I_GU + I_D;

__device__ __forceinline__ void prologue(const Params& p, LAS unsigned char* lds) {
    int tid_ = threadIdx.x; asm volatile("" : "+v"(tid_));
    const int lane = tid_ & 63, wave = __builtin_amdgcn_readfirstlane(tid_ >> 6), gw = blockIdx.x * 8 + wave, NGW = gridDim.x * 8; (void)wave;
    unsigned char* ws = p.ws;
    LAS float* scr = (LAS float*)(lds + wave * 16384);
    const int nl = lane & 31;
    for (int it = gw; it < 2 * I_LAYER; it += NGW) {
        const int l = it / I_LAYER; int r = it - l * I_LAYER;
        unsigned char* wl = ws + WS_W + (size_t)l * W_LAYER;
        if (r < I_IN) { const int nblk = 96, kb = r / nblk, nb = r % nblk, n = nb * 32 + nl;
            const float* src = INP(p, 3) + (size_t)l * 1024 * 2976; const float* sp = n < 928 ? src + n : (n < 1024 ? nullptr : src + (n - 96));
            tr_item(sp, 2976, INP(p, 2) + l * 1024, kb * 64, (bf16*)(wl + W_IN) + (size_t)nb * 32 * 1024, 1024, scr, lane); continue; } r -= I_IN;
        if (r < I_UQ) { const int nblk = 48, kb = r / nblk, nb = r % nblk, n = nb * 32 + nl;
            const float* src = INP(p, 8) + (size_t)l * 256 * 1536; const int pp = n & 31, rd = (pp & 4) ? 16 + 4 * (pp >> 3) + (pp & 3) : 4 * (pp >> 3) + (pp & 3); const int sc = n < 1024 ? (n >> 6) * 96 + (n & 63) : ((n - 1024) >> 5) * 96 + 64 + rd;
            tr_item(src + sc, 1536, nullptr, kb * 64, (bf16*)(wl + W_UQ) + (size_t)nb * 32 * 256, 256, scr, lane); continue; } r -= I_UQ;
        if (r < I_UKV) { const int nblk = 64, kb = r / nblk, nb = r % nblk, n = nb * 32 + nl;
            const float* src = INP(p, 9) + (size_t)l * 128 * 2048;
            tr_item(src + n, 2048, nullptr, kb * 64, (bf16*)(wl + W_UKV) + (size_t)nb * 32 * 128, 128, scr, lane); continue; } r -= I_UKV;
        if (r < I_PB) { const int nblk = 32, kb = r / nblk, nb = r % nblk, n = nb * 32 + nl;
            const float* src = INP(p, 11) + (size_t)l * 1024 * 1024;
            tr_item(src + n, 1024, nullptr, kb * 64, (bf16*)(wl + W_PB) + (size_t)nb * 32 * 1024, 1024, scr, lane); continue; } r -= I_PB;
        if (r < I_O) { const int nblk = 32, kb = r / nblk, nb = r % nblk, n = nb * 32 + nl;
            const float* src = INP(p, 12) + (size_t)l * 1024 * 1024;
            tr_item(src + n, 1024, nullptr, kb * 64, (bf16*)(wl + W_O) + (size_t)nb * 32 * 1024, 1024, scr, lane); continue; } r -= I_O;
        if (r < I_GU) { const int nblk = 176, kb = r / nblk, nb = r % nblk;
            const float* src = ((nl & 4) ? INP(p, 15) : INP(p, 14)) + (size_t)l * 1024 * DFF + nb * 16 + 4 * (nl >> 3) + (nl & 3);
            tr_item(src, DFF, INP(p, 13) + l * 1024, kb * 64, (bf16*)(wl + W_GU) + (size_t)nb * 32 * 1024, 1024, scr, lane); continue; } r -= I_GU;
        { const int nblk = 32, kb = r / nblk, nb = r % nblk, n = nb * 32 + nl;
            const float* src = INP(p, 16) + (size_t)l * DFF * 1024;
            tr_item(src + n, 1024, nullptr, kb * 64, (bf16*)(wl + W_D) + (size_t)nb * 32 * DFF, DFF, scr, lane); }
    }
    { const int gt = gw * 64 + lane, NT = NGW * 64;
      for (int idx = gt; idx < 2 * 65536; idx += NT) {
          const int l = idx >> 16, r = idx & 65535, n = r & 1023, kc = r >> 10, g = kc >> 4, i0 = (kc & 15) * 8;
          const float* pw = INP(p, 4) + (size_t)l * 4 * 128 * 128 + (size_t)g * 128 * 128 + (size_t)i0 * 128;
          const float* psc = INP(p, 5) + l * 512 + g * 128;
          const float* wpa = INP(p, 10) + (size_t)l * 512 * 1024 + (size_t)g * 128 * 1024 + n;
          float a[8] = {0.f, 0.f, 0.f, 0.f, 0.f, 0.f, 0.f, 0.f};
          for (int j = 0; j < 128; ++j) { const float w = psc[j] * wpa[(size_t)j * 1024];
#pragma unroll
              for (int e = 0; e < 8; ++e) a[e] += pw[e * 128 + j] * w; }
          u32x4 o; o.x = pk2(a[0], a[1]); o.y = pk2(a[2], a[3]); o.z = pk2(a[4], a[5]); o.w = pk2(a[6], a[7]);
          *(u32x4*)((bf16*)(ws + WS_W + (size_t)l * W_LAYER + W_C) + (size_t)n * 512 + kc * 8) = o; }
      float* cs = (float*)(ws + WS_COS); float* sn = (float*)(ws + WS_SIN);
      for (int idx = gt; idx < L * 16; idx += NT) { const int t = idx >> 4, i = idx & 15;
          const float inv = 1.0f / powf(10000.0f, (float)(2 * i) / 32.0f); const float ang = (float)t * inv;
          const double a = (double)ang; const double k = rint(a * 0.15915494309189535); const double rr = a - k * 6.283185307179586;
          const double r2 = rr * rr;
          double sv = rr * (1.0 + r2 * (-1.0/6 + r2 * (1.0/120 + r2 * (-1.0/5040 + r2 * (1.0/362880 + r2 * (-1.0/39916800 + r2 * (1.0/6227020800.0 + r2 * (-1.0/1307674368000.0 + r2 * (1.0/355687428096000.0)))))))));
          double cv = 1.0 + r2 * (-0.5 + r2 * (1.0/24 + r2 * (-1.0/720 + r2 * (1.0/40320 + r2 * (-1.0/3628800 + r2 * (1.0/479001600.0 + r2 * (-1.0/87178291200.0 + r2 * (1.0/20922789888000.0 + r2 * (-1.0/6402373705728000.0)))))))));
          cs[idx] = (float)cv; sn[idx] = (float)sv; }
    }
    { bf16* hb = (bf16*)(ws + WS_HB); float* ss = (float*)(ws + WS_SS);
      for (int m = gw; m < M; m += NGW) { const int b = m / L, t = m - b * L;
          const float* src = t < NMETA ? INP(p, 1) + (size_t)t * D : INP(p, 0) + ((size_t)b * SEQ + (t - NMETA)) * D;
          float s = 0.f;
#pragma unroll
          for (int j = 0; j < 4; ++j) { const f32x4 v = *(const f32x4*)(src + 256 * j + 4 * lane); s += (v[0] * v[0] + v[1] * v[1]) + (v[2] * v[2] + v[3] * v[3]);
              u32x2 w; w.x = pk2(v[0], v[1]); w.y = pk2(v[2], v[3]); *(u32x2*)(hb + (size_t)m * 1024 + 256 * j + 4 * lane) = w; }
          s = wave_sum(s);
          if (lane < 16) ss[(size_t)m * 16 + lane] = lane == 0 ? s : 0.f; }
    }
}

__device__ __forceinline__ void phase_elem(const Params& p, int l) {
    int tid_ = threadIdx.x; asm volatile("" : "+v"(tid_));
    const int lane = tid_ & 63, wave = __builtin_amdgcn_readfirstlane(tid_ >> 6), gw = blockIdx.x * 8 + wave, NGW = gridDim.x * 8; (void)wave;
    unsigned char* ws = p.ws;
    const bf16* Z1 = (const bf16*)(ws + WS_Z1); bf16* Y = (bf16*)((unsigned char*)p.out + OUT_Y); bf16* CQ = (bf16*)((unsigned char*)p.out + OUT_CQ); bf16* CKV = (bf16*)((unsigned char*)p.out + OUT_CKV); bf16* KR = (bf16*)(ws + WS_KR);
    const float* cs = (const float*)(ws + WS_COS); const float* sn = (const float*)(ws + WS_SIN);
    const float* qg = INP(p, 6) + l * 256; const float* kg = INP(p, 7) + l * 128;
    const f32x4 qg4 = *(const f32x4*)(qg + 4 * lane); const float kg0 = kg[2 * lane], kg1 = kg[2 * lane + 1];
    const int grp = lane >> 4, win = 2 << grp;
    for (int m = gw; m < M; m += NGW) { const int b = m / L, t = m - b * L; const bf16* z = Z1 + (size_t)m * 1024;
        { const u32x2 v = *(const u32x2*)(z + 512 + 4 * lane); const float a0 = bflo(v.x), a1 = bfhi(v.x), a2 = bflo(v.y), a3 = bfhi(v.y);
          const float s = wave_sum((a0 * a0 + a1 * a1) + (a2 * a2 + a3 * a3)); const float rs = rsqrtf(s * (1.0f / 256.0f) + EPS);
          u32x2 w; w.x = pk2(a0 * rs * qg4[0], a1 * rs * qg4[1]); w.y = pk2(a2 * rs * qg4[2], a3 * rs * qg4[3]); *(u32x2*)(CQ + (size_t)m * 256 + 4 * lane) = w; }
        { const unsigned v = *(const unsigned*)(z + 768 + 2 * lane); const float a0 = bflo(v), a1 = bfhi(v);
          const float s = wave_sum(a0 * a0 + a1 * a1); const float rs = rsqrtf(s * (1.0f / 128.0f) + EPS);
          *(unsigned*)(CKV + (size_t)m * 128 + 2 * lane) = pk2(a0 * rs * kg0, a1 * rs * kg1); }
        if (lane < 16) { const float x1 = bf1(z[896 + lane]), x2 = bf1(z[912 + lane]); const float c = cs[t * 16 + lane], s = sn[t * 16 + lane];
          const int kp = 8 * (lane >> 2) + (lane & 3); KR[(size_t)m * 32 + kp] = (bf16)(pk2(x1 * c - x2 * s, 0.f) & 0xffffu); KR[(size_t)m * 32 + kp + 4] = (bf16)(pk2(x1 * s + x2 * c, 0.f) & 0xffffu); }
        { const int cnt = (t + 1) < win ? (t + 1) : win; float sum[8], cur[8];
          { const u32x4 v = *(const u32x4*)(z + 8 * lane); cur[0] = bflo(v.x); cur[1] = bfhi(v.x); cur[2] = bflo(v.y); cur[3] = bfhi(v.y); cur[4] = bflo(v.z); cur[5] = bfhi(v.z); cur[6] = bflo(v.w); cur[7] = bfhi(v.w); }
#pragma unroll
          for (int e = 0; e < 8; ++e) sum[e] = cur[e];
#pragma unroll
          for (int j = 1; j < 16; ++j) if (j < cnt) { const u32x4 v = *(const u32x4*)(z - (size_t)j * 1024 + 8 * lane);
              sum[0] += bflo(v.x); sum[1] += bfhi(v.x); sum[2] += bflo(v.y); sum[3] += bfhi(v.y); sum[4] += bflo(v.z); sum[5] += bfhi(v.z); sum[6] += bflo(v.w); sum[7] += bfhi(v.w); }
          const float ic = 1.0f / (float)cnt; u32x4 o;
          o.x = pk2(sum[0] * ic - cur[0], sum[1] * ic - cur[1]); o.y = pk2(sum[2] * ic - cur[2], sum[3] * ic - cur[3]);
          o.z = pk2(sum[4] * ic - cur[4], sum[5] * ic - cur[5]); o.w = pk2(sum[6] * ic - cur[6], sum[7] * ic - cur[7]);
          *(u32x4*)(Y + (size_t)m * 512 + 8 * lane) = o; }
    }
}

__device__ __forceinline__ void phase_final(const Params& p) {
    int tid_ = threadIdx.x; asm volatile("" : "+v"(tid_));
    const int lane = tid_ & 63, wave = __builtin_amdgcn_readfirstlane(tid_ >> 6), gw = blockIdx.x * 8 + wave, NGW = gridDim.x * 8;
    const float* ss = (const float*)(p.ws + WS_SS); const float* g = INP(p, 17); const bf16* hb = (const bf16*)(p.ws + WS_HB);
    const f32x4 g0 = *(const f32x4*)(g + 8 * lane), g1 = *(const f32x4*)(g + 8 * lane + 4), g2 = *(const f32x4*)(g + 512 + 8 * lane), g3 = *(const f32x4*)(g + 512 + 8 * lane + 4);
    for (int r = gw; r < NB * SEQ; r += NGW) { const int b = r / SEQ, t = r - b * SEQ; const int m = b * L + NMETA + t;
        const float rs = row_rstd(ss, m); float* o = p.out + (size_t)r * D; const bf16* h = hb + (size_t)m * 1024;
        const u32x4 a = *(const u32x4*)(h + 8 * lane), c2 = *(const u32x4*)(h + 512 + 8 * lane);
        *(f32x4*)(o + 8 * lane) = pg8::unlo(a) * rs * g0; *(f32x4*)(o + 8 * lane + 4) = pg8::unhi(a) * rs * g1;
        *(f32x4*)(o + 512 + 8 * lane) = pg8::unlo(c2) * rs * g2; *(f32x4*)(o + 512 + 8 * lane + 4) = pg8::unhi(c2) * rs * g3; }
}

namespace att {
constexpr int KROW = 208, KBUF = 64 * KROW, VBUF = 8192, OFF_K = 0, OFF_V = 2 * KBUF, LDS_BYTES = 2 * KBUF + 2 * VBUF;
__device__ __forceinline__ int crow(int r, int hi) { return (r & 3) + 8 * (r >> 2) + 4 * hi; }
#define ATT_MFMA(a, b, c) __builtin_amdgcn_mfma_f32_32x32x16_bf16((a), (b), (c), 0, 0, 0)
typedef short v4i16_t __attribute__((ext_vector_type(4)));
__device__ __forceinline__ s16x4 vtr(const LAS unsigned char* p) { return __builtin_bit_cast(s16x4, __builtin_amdgcn_ds_read_tr16_b64_v4i16((LAS v4i16_t*)p)); }

__device__ __forceinline__ void attn_unit(LAS unsigned char* lds, const bf16* Q, const bf16* KV, const bf16* KR, bf16* AO, int b, int h, int qi) {
    int tid_ = threadIdx.x; asm volatile("" : "+v"(tid_));
    const int tid = tid_, lane = tid & 63, wid = tid >> 6, r32 = lane & 31, hi = lane >> 5;
    const int row0 = NMETA + 256 * (qi - 1), nt = 4 * qi + 1;
    const int qrow = row0 + 32 * wid + r32, qrc = qrow < 0 ? 0 : qrow;
    const size_t rb = (size_t)b * L;
    bf16x8 qf[6];
    { const bf16* qp = Q + (rb + qrc) * 1536;
#pragma unroll
      for (int d0 = 0; d0 < 4; ++d0) qf[d0] = *(const bf16x8*)(qp + h * 64 + 16 * d0 + 8 * hi);
#pragma unroll
      for (int d0 = 4; d0 < 6; ++d0) qf[d0] = *(const bf16x8*)(qp + 1024 + h * 32 + 16 * (d0 - 4) + 8 * hi); }
    const int lk = tid >> 3, lc = tid & 7, rk = (tid >> 2) & 63, rc = tid & 3;
    u32x4 pk_ = {0, 0, 0, 0}, pv_ = {0, 0, 0, 0}, pr_ = {0, 0, 0, 0};
#define ATT_GLOAD(kt) do { int kg = 64 * (kt) + lk; kg = kg > L - 1 ? L - 1 : kg; const bf16* kp = KV + (rb + kg) * 2048 + h * 128 + lc * 8; pk_ = *(const u32x4*)kp; pv_ = *(const u32x4*)(kp + 64); \
        if (tid < 256) { int kg2 = 64 * (kt) + rk; kg2 = kg2 > L - 1 ? L - 1 : kg2; pr_ = *(const u32x4*)(KR + (rb + kg2) * 32 + rc * 8); } } while (0)
#define ATT_LSTORE(bufi) do { *(LAS u32x4*)(lds + OFF_K + (bufi) * KBUF + lk * KROW + lc * 16) = pk_; *(LAS u32x4*)(lds + OFF_V + (bufi) * VBUF + (lc >> 2) * 4096 + lk * 64 + (lc & 3) * 16) = pv_; \
        if (tid < 256) *(LAS u32x4*)(lds + OFF_K + (bufi) * KBUF + rk * KROW + 128 + rc * 16) = pr_; } while (0)
    float mrun = -INFINITY, lrun = 0.f; f32x16 o0, o1;
#pragma unroll
    for (int i = 0; i < 16; ++i) { o0[i] = 0.f; o1[i] = 0.f; }
    ATT_GLOAD(0); ATT_LSTORE(0); __syncthreads();
    for (int kt = 0; kt < nt; ++kt) {
        const int buf = kt & 1;
        if (kt + 1 < nt) ATT_GLOAD(kt + 1);
        f32x16 p0, p1;
#pragma unroll
        for (int i = 0; i < 16; ++i) { p0[i] = 0.f; p1[i] = 0.f; }
        const LAS unsigned char* kb = lds + OFF_K + buf * KBUF + r32 * KROW + hi * 16;
#pragma unroll
        for (int d0 = 0; d0 < 6; ++d0) { const bf16x8 a0 = *(const LAS bf16x8*)(kb + d0 * 32), a1 = *(const LAS bf16x8*)(kb + 32 * KROW + d0 * 32);
            p0 = ATT_MFMA(a0, qf[d0], p0); p1 = ATT_MFMA(a1, qf[d0], p1); }
        if (64 * kt + 63 > row0 + 32 * wid) {
#pragma unroll
            for (int i = 0; i < 16; ++i) { const int key = 64 * kt + crow(i, hi); if (key > qrc) p0[i] = -INFINITY; if (key + 32 > qrc) p1[i] = -INFINITY; }
        }
        float mx = fmaxf(p0[0], p1[0]);
#pragma unroll
        for (int i = 1; i < 16; ++i) mx = fmaxf(mx, fmaxf(p0[i], p1[i]));
        mx = fmaxf(mx, __shfl_xor(mx, 32));
        const float mnew = fmaxf(mrun, mx), alpha = __builtin_amdgcn_exp2f(mrun - mnew);
        float ls = 0.f;
#pragma unroll
        for (int i = 0; i < 16; ++i) { p0[i] = __builtin_amdgcn_exp2f(p0[i] - mnew); p1[i] = __builtin_amdgcn_exp2f(p1[i] - mnew); ls += p0[i] + p1[i]; }
        lrun = lrun * alpha + ls; mrun = mnew;
#pragma unroll
        for (int i = 0; i < 16; ++i) { o0[i] *= alpha; o1[i] *= alpha; }
        bf16x8 pa[4];
#pragma unroll
        for (int s = 0; s < 2; ++s) { u32x4 w;
            w.x = pk2(p0[8 * s + 0], p0[8 * s + 1]); w.y = pk2(p0[8 * s + 2], p0[8 * s + 3]); w.z = pk2(p0[8 * s + 4], p0[8 * s + 5]); w.w = pk2(p0[8 * s + 6], p0[8 * s + 7]); pa[s] = __builtin_bit_cast(bf16x8, w);
            w.x = pk2(p1[8 * s + 0], p1[8 * s + 1]); w.y = pk2(p1[8 * s + 2], p1[8 * s + 3]); w.z = pk2(p1[8 * s + 4], p1[8 * s + 5]); w.w = pk2(p1[8 * s + 6], p1[8 * s + 7]); pa[2 + s] = __builtin_bit_cast(bf16x8, w); }
        const LAS unsigned char* vb = lds + OFF_V + buf * VBUF + (4 * hi + ((lane & 15) >> 2)) * 64 + ((lane >> 4) & 1) * 32 + (lane & 3) * 8;
#pragma unroll
        for (int ks = 0; ks < 4; ++ks) {
            const s16x4 l0 = vtr(vb + ks * 1024), h0 = vtr(vb + ks * 1024 + 512), l1 = vtr(vb + 4096 + ks * 1024), h1 = vtr(vb + 4096 + ks * 1024 + 512);
            const bf16x8 v0 = {l0[0], l0[1], l0[2], l0[3], h0[0], h0[1], h0[2], h0[3]}, v1 = {l1[0], l1[1], l1[2], l1[3], h1[0], h1[1], h1[2], h1[3]};
            o0 = ATT_MFMA(v0, pa[ks], o0); o1 = ATT_MFMA(v1, pa[ks], o1); }
        if (kt + 1 < nt) ATT_LSTORE(buf ^ 1);
        __syncthreads();
    }
    const float lt = lrun + __shfl_xor(lrun, 32), inv = 1.0f / lt;
    if (qrow >= 0) { bf16* op = AO + (rb + qrow) * 1024 + h * 64;
#pragma unroll
        for (int g = 0; g < 4; ++g) { u32x2 w0, w1;
            w0.x = pk2(o0[4 * g] * inv, o0[4 * g + 1] * inv); w0.y = pk2(o0[4 * g + 2] * inv, o0[4 * g + 3] * inv);
            w1.x = pk2(o1[4 * g] * inv, o1[4 * g + 1] * inv); w1.y = pk2(o1[4 * g + 2] * inv, o1[4 * g + 3] * inv);
            *(u32x2*)(op + 8 * g + 4 * hi) = w0; *(u32x2*)(op + 32 + 8 * g + 4 * hi) = w1; } }
#undef ATT_GLOAD
#undef ATT_LSTORE
}
}

#ifndef DUP_MASK
#define DUP_MASK 0
#endif
constexpr int LDS_BYTES = 131072 + 1024;
__global__ void __launch_bounds__(512, 2) mk_fwd(Params p) {
    extern __shared__ __attribute__((aligned(16))) unsigned char lds_raw[];
    LAS unsigned char* lds = (LAS unsigned char*)lds_raw;
    const int G = gridDim.x;
    unsigned char* ws = p.ws;
    const int lo = p.ph_lo, hi = p.ph_hi;
#define IN(k) (lo <= (k) && (k) < hi)
#define SEAM(k) do { if (IN(k) && IN((k) + 1)) { cg::this_grid().sync(); } } while (0)
    bf16* HB = (bf16*)(ws + WS_HB); float* SS = (float*)(ws + WS_SS); bf16* ZG = (bf16*)(ws + WS_ZG);

    if (IN(0)) for (int rep_ = 0; rep_ < 1 + ((DUP_MASK >> 8) & 1); ++rep_) { if (rep_) cg::this_grid().sync(); prologue(p, lds); }
    SEAM(0);
    for (int l = 0; l < 2; ++l) {
        const int pb = 1 + 8 * l;
        unsigned char* wl = ws + WS_W + (size_t)l * W_LAYER;
        if (IN(pb + 0)) for (int rep_ = 0; rep_ < 1 + ((DUP_MASK >> 0) & 1); ++rep_) { if (rep_) cg::this_grid().sync();
            pg8::Gemm g{HB, (const bf16*)(wl + W_IN), M, NZ, 1024}; pg8::StaticOrder S; S.init(M, NZ, G, (int)blockIdx.x);
            pg8::EpiZ E{SS, (bf16*)(ws + WS_Z1), ZG};
            pg8::gemm_phase<pg8::EpiZ, pg8::StaticOrder, true, true>(lds, g, S, E);
        }
        SEAM(pb + 0);
        if (IN(pb + 1)) for (int rep_ = 0; rep_ < 1 + ((DUP_MASK >> 1) & 1); ++rep_) { if (rep_) cg::this_grid().sync(); phase_elem(p, l); }
        SEAM(pb + 1);
        if (IN(pb + 2)) for (int rep_ = 0; rep_ < 1 + ((DUP_MASK >> 2) & 1); ++rep_) { if (rep_) cg::this_grid().sync();
            { pg8::Gemm g{(const bf16*)((unsigned char*)p.out + OUT_CQ), (const bf16*)(wl + W_UQ), M, 1536, 256}; pg8::StaticOrder S; S.init(M, 1536, G, (int)blockIdx.x);
              pg8::EpiQ E{(bf16*)(ws + WS_Q), (const float*)(ws + WS_COS), (const float*)(ws + WS_SIN)};
              pg8::gemm_phase<pg8::EpiQ, pg8::StaticOrder, true, true>(lds, g, S, E); }
            { pg8::Gemm g{(const bf16*)((unsigned char*)p.out + OUT_CKV), (const bf16*)(wl + W_UKV), M, 2048, 128}; pg8::StaticOrder S; S.init(M, 2048, G, (int)blockIdx.x);
              pg8::EpiBf E{(bf16*)(ws + WS_KV), 2048};
              pg8::gemm_phase<pg8::EpiBf, pg8::StaticOrder, true, true>(lds, g, S, E); }
            { pg8::Gemm g{(const bf16*)((unsigned char*)p.out + OUT_Y), (const bf16*)(wl + W_C), M, 1024, 512}; pg8::StaticOrder S; S.init(M, 1024, G, (int)blockIdx.x);
              pg8::EpiTA E{ZG};
              pg8::gemm_phase<pg8::EpiTA, pg8::StaticOrder, true, true>(lds, g, S, E); }
        }
        SEAM(pb + 2);
        if (IN(pb + 3)) for (int rep_ = 0; rep_ < 1 + ((DUP_MASK >> 3) & 1); ++rep_) { if (rep_) cg::this_grid().sync();
            for (int bh = blockIdx.x; bh < NB * NH; bh += G)
                for (int qi = 8; qi >= 0; --qi)
                    att::attn_unit(lds, (const bf16*)(ws + WS_Q), (const bf16*)(ws + WS_KV), (const bf16*)(ws + WS_KR), (bf16*)((unsigned char*)p.out + OUT_AO), bh / NH, bh % NH, qi);
        }
        SEAM(pb + 3);
        if (IN(pb + 4)) for (int rep_ = 0; rep_ < 1 + ((DUP_MASK >> 4) & 1); ++rep_) { if (rep_) cg::this_grid().sync();
            pg8::Gemm g{(const bf16*)((unsigned char*)p.out + OUT_AO), (const bf16*)(wl + W_PB), M, 1024, 1024}; pg8::StaticOrder S; S.init(M, 1024, G, (int)blockIdx.x);
            pg8::EpiMG E{ZG, (bf16*)(ws + WS_MG)};
            pg8::gemm_phase<pg8::EpiMG, pg8::StaticOrder, true, true>(lds, g, S, E);
        }
        SEAM(pb + 4);
        if (IN(pb + 5)) for (int rep_ = 0; rep_ < 1 + (((DUP_MASK >> 5) & 1) && l == 0 ? 1 : 0); ++rep_) { if (rep_) cg::this_grid().sync();
            pg8::Gemm g{(const bf16*)(ws + WS_MG), (const bf16*)(wl + W_O), M, 1024, 1024}; pg8::StaticOrder S; S.init(M, 1024, G, (int)blockIdx.x);
            pg8::EpiRes E{INP(p, 0), INP(p, 1), l == 0, HB, SS};
            pg8::gemm_phase<pg8::EpiRes, pg8::StaticOrder, true, true>(lds, g, S, E);
        }
        SEAM(pb + 5);
        if (IN(pb + 6)) for (int rep_ = 0; rep_ < 1 + ((DUP_MASK >> 6) & 1); ++rep_) { if (rep_) cg::this_grid().sync();
            pg8::Gemm g{HB, (const bf16*)(wl + W_GU), M, 2 * DFF, 1024}; pg8::StaticOrder S; S.init(M, 2 * DFF, G, (int)blockIdx.x);
            pg8::EpiSw E{SS, (bf16*)(ws + WS_ACT)};
            pg8::gemm_phase<pg8::EpiSw, pg8::StaticOrder, true, true>(lds, g, S, E);
        }
        SEAM(pb + 6);
        if (IN(pb + 7)) for (int rep_ = 0; rep_ < 1 + ((DUP_MASK >> 7) & 1); ++rep_) { if (rep_) cg::this_grid().sync();
            pg8::Gemm g{(const bf16*)(ws + WS_ACT), (const bf16*)(wl + W_D), M, 1024, DFF}; pg8::StaticOrder S; S.init(M, 1024, G, (int)blockIdx.x);
            pg8::EpiRes E{INP(p, 0), INP(p, 1), false, HB, SS};
            pg8::gemm_phase<pg8::EpiRes, pg8::StaticOrder, true, true>(lds, g, S, E);
        }
        SEAM(pb + 7);
    }
    if (IN(17)) { phase_final(p); }
#undef IN
#undef SEAM
}

extern "C" void kernel_launch(void* const* d_in, const int* in_sizes, int n_in, void* d_out, int out_size, void* d_ws, size_t ws_size, hipStream_t stream) {
    static int grid = 0;
    if (grid == 0) {
        if (n_in != 18 || out_size != NB * SEQ * D || ws_size < WS_END) { fprintf(stderr, "kernel_launch: unexpected shapes (n_in %d out %d ws %zu need %zu)\n", n_in, out_size, ws_size, (size_t)WS_END); grid = -1; return; }
        int dev = 0, cus = 0, per_cu = 0;
        hipGetDevice(&dev); hipDeviceGetAttribute(&cus, hipDeviceAttributeMultiprocessorCount, dev);
        if (hipFuncSetAttribute((const void*)mk_fwd, hipFuncAttributeMaxDynamicSharedMemorySize, LDS_BYTES) != hipSuccess) { fprintf(stderr, "kernel_launch: hipFuncSetAttribute failed\n"); grid = -1; return; }
        if (hipOccupancyMaxActiveBlocksPerMultiprocessor(&per_cu, (const void*)mk_fwd, 512, LDS_BYTES) != hipSuccess || per_cu < 1) { fprintf(stderr, "kernel_launch: occupancy query says %d\n", per_cu); per_cu = 1; }
        (void)hipGetLastError();
        grid = cus;
    }
    if (grid < 0) return;
    Params p{};
    for (int i = 0; i < 18; ++i) p.in[i] = (const float*)d_in[i];
    p.out = (float*)d_out; p.ws = (unsigned char*)d_ws;
#if MK_COOP
    p.ph_lo = 0; p.ph_hi = NPHASE;
    void* args[] = {&p};
    hipError_t e = hipLaunchCooperativeKernel((const void*)mk_fwd, dim3(grid), dim3(512), args, LDS_BYTES, stream);
    if (e != hipSuccess) fprintf(stderr, "kernel_launch: cooperative launch failed: %s (grid %d)\n", hipGetErrorString(e), grid);
#else
    for (int k = 0; k < NPHASE; ++k) { p.ph_lo = k; p.ph_hi = k + 1; hipLaunchKernelGGL(mk_fwd, dim3(grid), dim3(512), LDS_BYTES, stream, p); }
#endif
}
```

```cpp
#include <hip/hip_runtime.h>
#include <hip/hip_cooperative_groups.h>
#include <cstdio>
#include <cstdint>
#include <cmath>
namespace cg = cooperative_groups;
namespace pg8 {
#define PG8_LAS __attribute__((address_space(3)))
typedef unsigned short bf16_t;
typedef short bf16x8 __attribute__((ext_vector_type(8)));
typedef float f32x4 __attribute__((ext_vector_type(4)));
typedef unsigned u32x4 __attribute__((ext_vector_type(4)));
constexpr int BM = 256, BK = 64, HALF = 128, HTB = HALF * BK * 2  , STAGE_BYTES = 8 * HTB, NXCD = 8, WGM = 8;

__host__ __device__ __forceinline__ int lds_byte(int r, int c) { const int st = (r >> 4) * 2 + (c >> 5), rr = r & 15, cc = c & 31, ob = rr * 64 + cc * 2; return st * 1024 + (ob ^ (((ob >> 9) & 1) << 5)); }
__host__ __device__ __forceinline__ void stage_rc(int b, int& R, int& C) { const int st = b / 1024, sb = b % 1024, swz = sb ^ (((sb >> 9) & 1) << 5); R = (st >> 1) * 16 + swz / 64; C = (st & 1) * 32 + (swz % 64) / 2; }
__host__ __device__ __forceinline__ int perm32(int rho) { const int n = rho >> 4, i = rho & 15; return 8 * (i >> 2) + 4 * n + (i & 3); }

struct Unit { int pm, pn; };
struct Gemm { const bf16_t* A; const bf16_t* Bt; int M, N, K; };

struct StaticOrder {
    int nM, nN, nwg, G, c;
    __host__ __device__ void init(int M, int N, int G_, int c_) { nM = M / BM; nN = N / BM; nwg = nM * nN; G = G_; c = c_; }
    __host__ __device__ bool next(int i, Unit& u) const {
        const long L = (long)i * G + c; if (L >= nwg) return false;
        int wgid = (int)L; { const int q = nwg / NXCD, r = nwg % NXCD, xcd = wgid % NXCD, off = wgid / NXCD; wgid = (xcd < r ? xcd * (q + 1) : r * (q + 1) + (xcd - r) * q) + off; }
        const int nig = WGM * nN, gid = wgid / nig, fm = gid * WGM, gsz = (nM - fm) < WGM ? (nM - fm) : WGM;
        u.pm = fm + ((wgid % nig) % gsz); u.pn = (wgid % nig) / gsz; return true;
    }
    __device__ __forceinline__ void a_ready(const Unit&) const {}
    __device__ __forceinline__ void done(const Unit&) const {}
};

template <class Epi, class Sched, bool ALIGN_EPI = false, bool SP2 = false>
__device__ __forceinline__ void gemm_phase(PG8_LAS unsigned char* lds, const Gemm g, const Sched& S, const Epi& E) {
    int tid_ = threadIdx.x; asm volatile("" : "+v"(tid_));
    const int tid = tid_, wid = __builtin_amdgcn_readfirstlane(tid >> 6), lane = tid & 63, wr = wid >> 2, wc = wid & 3, fr = lane & 15, fq = lane >> 4;
    int K_ = g.K; asm volatile("" : "+s"(K_));
    const int K = K_, nt = K / BK;
    unsigned voffA[2], voffB[2];
#pragma unroll
    for (int i = 0; i < 2; ++i) { int R, C; stage_rc(tid * 16 + i * 8192, R, C); const int Rb = Epi::PERM ? ((R & ~31) + perm32(R & 31)) : R;
        voffA[i] = (unsigned)(R * K + C) * 2u; voffB[i] = (unsigned)(Rb * K + C) * 2u; }
    const size_t kstep = (size_t)(BK * 2);
    const size_t hstep = (size_t)HALF * K * 2;
    const size_t tstep = 2 * hstep;
    const unsigned ldsw = (unsigned)wid * 1024u;
    const int aoff = lds_byte(wr * 64 + fr, fq * 8), boff = lds_byte(wc * 32 + fr, fq * 8);
#define PG8_SA(b, h) (((b) * 2 + (h)) * HTB)
#define PG8_SB(b, h) ((4 + (b) * 2 + (h)) * HTB)
#define PG8_STAGE(bufoff, gbase, voff) do { _Pragma("unroll") for (int _i = 0; _i < 2; ++_i) \
        __builtin_amdgcn_global_load_lds((const unsigned*)((const char*)(gbase) + (voff)[_i]), (PG8_LAS unsigned*)(lds + (bufoff) + ldsw + _i * 8192), 16, 0, 0); } while (0)
#define PG8_LDA(dst, b, h) do { _Pragma("unroll") for (int m = 0; m < 4; ++m) _Pragma("unroll") for (int k = 0; k < 2; ++k) dst[m][k] = *(const PG8_LAS bf16x8*)(lds + PG8_SA(b, h) + aoff + m * 2048 + k * 1024); } while (0)
#define PG8_LDB(dst, b, h) do { _Pragma("unroll") for (int n = 0; n < 2; ++n) _Pragma("unroll") for (int k = 0; k < 2; ++k) dst[n][k] = *(const PG8_LAS bf16x8*)(lds + PG8_SB(b, h) + boff + n * 2048 + k * 1024); } while (0)
#define PG8_MMA(ai, bj, At, Bt) do { __builtin_amdgcn_s_setprio(1); _Pragma("unroll") for (int m = 0; m < 4; ++m) _Pragma("unroll") for (int n = 0; n < 2; ++n) _Pragma("unroll") for (int k = 0; k < 2; ++k) \
        acc[ai][bj][m][n] = __builtin_amdgcn_mfma_f32_16x16x32_bf16(Bt[n][k], At[m][k], acc[ai][bj][m][n], 0, 0, 0); __builtin_amdgcn_s_setprio(0); } while (0)
#define PG8_WAIT_V(n) asm volatile("s_waitcnt vmcnt(" #n ")" ::: "memory")
#define PG8_WAIT_L(n) asm volatile("s_waitcnt lgkmcnt(" #n ")" ::: "memory")
#define PG8_BAR __builtin_amdgcn_s_barrier()
#define PG8_SCHED __builtin_amdgcn_sched_barrier(0)
    Unit cur, nxt; int ui = 0;
    if (!S.next(0, cur)) return;
    f32x4 acc[2][2][4][2];
#pragma unroll
    for (int a = 0; a < 2; ++a)
#pragma unroll
        for (int b = 0; b < 2; ++b)
#pragma unroll
            for (int m = 0; m < 4; ++m)
#pragma unroll
                for (int n = 0; n < 2; ++n) acc[a][b][m][n] = (f32x4){0.f, 0.f, 0.f, 0.f};
    bf16x8 At[4][2], B0[2][2], B1[2][2];
    const char* cA = (const char*)g.A + (size_t)cur.pm * tstep; const char* cB = (const char*)g.Bt + (size_t)cur.pn * tstep;
    S.a_ready(cur);
    if constexpr (SP2) {
        PG8_STAGE(PG8_SB(0, 0), cB, voffB); PG8_STAGE(PG8_SB(0, 1), cB + hstep, voffB); PG8_STAGE(PG8_SA(0, 0), cA, voffA); PG8_STAGE(PG8_SA(0, 1), cA + hstep, voffA);
        if (wr == 1) PG8_BAR;
        PG8_WAIT_V(2); PG8_BAR;
        PG8_STAGE(PG8_SB(1, 0), cB + kstep, voffB); PG8_STAGE(PG8_SA(1, 0), cA + kstep, voffA); PG8_STAGE(PG8_SB(1, 1), cB + hstep + kstep, voffB);
        PG8_WAIT_V(6); PG8_BAR;
    } else {
        PG8_STAGE(PG8_SB(0, 0), cB, voffB); PG8_STAGE(PG8_SA(0, 0), cA, voffA); PG8_STAGE(PG8_SB(0, 1), cB + hstep, voffB); PG8_STAGE(PG8_SA(0, 1), cA + hstep, voffA);
        if (wr == 1) PG8_BAR;
        PG8_WAIT_V(4); PG8_BAR;
        PG8_STAGE(PG8_SB(1, 0), cB + kstep, voffB); PG8_STAGE(PG8_SA(1, 0), cA + kstep, voffA); PG8_STAGE(PG8_SB(1, 1), cB + hstep + kstep, voffB);
        PG8_WAIT_V(6); PG8_BAR;
    }
    for (;;) {
        const bool has_next = S.next(ui + 1, nxt);
        const char* nA = has_next ? (const char*)g.A + (size_t)nxt.pm * tstep : cA; const char* nB = has_next ? (const char*)g.Bt + (size_t)nxt.pn * tstep : cB;
        for (int t = 0; t < nt; t += 2) {
            const bool last = (t == nt - 2);
            const char* a1 = cA + (size_t)(t + 1) * kstep;
            const char* a2 = last ? nA : cA + (size_t)(t + 2) * kstep; const char* b2 = last ? nB : cB + (size_t)(t + 2) * kstep;
            const char* a3 = a2 + kstep; const char* b3 = b2 + kstep;
            if (last && has_next) S.a_ready(nxt);
            if constexpr (SP2) {
            PG8_LDB(B0, 0, 0); PG8_LDB(B1, 0, 1); PG8_SCHED; PG8_LDA(At, 0, 0); PG8_STAGE(PG8_SA(1, 1), a1 + hstep, voffA);
            PG8_WAIT_V(8); PG8_WAIT_L(0); PG8_BAR; PG8_MMA(0, 0, At, B0); PG8_MMA(0, 1, At, B1); PG8_BAR; PG8_SCHED;
            PG8_LDA(At, 0, 1); PG8_STAGE(PG8_SB(0, 0), b2, voffB); PG8_STAGE(PG8_SB(0, 1), b2 + hstep, voffB); PG8_STAGE(PG8_SA(0, 0), a2, voffA);
            PG8_WAIT_V(8); PG8_WAIT_L(0); PG8_BAR; PG8_MMA(1, 0, At, B0); PG8_MMA(1, 1, At, B1); PG8_BAR; PG8_SCHED;
            PG8_LDB(B0, 1, 0); PG8_LDB(B1, 1, 1); PG8_SCHED; PG8_LDA(At, 1, 0); PG8_STAGE(PG8_SA(0, 1), a2 + hstep, voffA);
            PG8_WAIT_V(8); PG8_WAIT_L(0); PG8_BAR; PG8_MMA(0, 0, At, B0); PG8_MMA(0, 1, At, B1); PG8_BAR; PG8_SCHED;
            PG8_LDA(At, 1, 1); PG8_STAGE(PG8_SB(1, 0), b3, voffB); PG8_STAGE(PG8_SB(1, 1), b3 + hstep, voffB); PG8_STAGE(PG8_SA(1, 0), a3, voffA);
            PG8_WAIT_V(8); PG8_WAIT_L(0); PG8_BAR; PG8_MMA(1, 0, At, B0); PG8_MMA(1, 1, At, B1); PG8_BAR; PG8_SCHED;
            } else {
            PG8_LDB(B0, 0, 0); PG8_SCHED; PG8_LDA(At, 0, 0); PG8_STAGE(PG8_SA(1, 1), a1 + hstep, voffA);
            PG8_WAIT_L(8); PG8_BAR; PG8_WAIT_L(0); PG8_MMA(0, 0, At, B0); PG8_BAR; PG8_SCHED;
            PG8_LDB(B1, 0, 1); PG8_STAGE(PG8_SB(0, 0), b2, voffB);
            PG8_BAR; PG8_WAIT_L(0); PG8_MMA(0, 1, At, B1); PG8_BAR;
            PG8_LDA(At, 0, 1); PG8_STAGE(PG8_SA(0, 0), a2, voffA);
            PG8_BAR; PG8_WAIT_L(0); PG8_MMA(1, 0, At, B0); PG8_BAR; PG8_SCHED;
            PG8_STAGE(PG8_SB(0, 1), b2 + hstep, voffB);
            PG8_WAIT_V(6); PG8_BAR; PG8_MMA(1, 1, At, B1); PG8_BAR;
            PG8_LDB(B0, 1, 0); PG8_SCHED; PG8_LDA(At, 1, 0); PG8_STAGE(PG8_SA(0, 1), a2 + hstep, voffA);
            PG8_WAIT_L(8); PG8_BAR; PG8_WAIT_L(0); PG8_MMA(0, 0, At, B0); PG8_BAR; PG8_SCHED;
            PG8_LDB(B1, 1, 1); PG8_STAGE(PG8_SB(1, 0), b3, voffB);
            PG8_BAR; PG8_WAIT_L(0); PG8_MMA(0, 1, At, B1); PG8_BAR;
            PG8_LDA(At, 1, 1); PG8_STAGE(PG8_SA(1, 0), a3, voffA);
            PG8_BAR; PG8_WAIT_L(0); PG8_MMA(1, 0, At, B0); PG8_BAR; PG8_SCHED;
            PG8_STAGE(PG8_SB(1, 1), b3 + hstep, voffB);
            PG8_WAIT_V(6); PG8_BAR; PG8_MMA(1, 1, At, B1); PG8_BAR;
            }
        }
        if constexpr (ALIGN_EPI) { if (wr == 0) PG8_BAR; }
        if constexpr (!Epi::AFTER_DRAIN) { E(acc, cur, wr, wc, fr, fq); S.done(cur); }
        if (!has_next) break;
#pragma unroll
        for (int a = 0; a < 2; ++a)
#pragma unroll
            for (int b = 0; b < 2; ++b)
#pragma unroll
                for (int m = 0; m < 4; ++m)
#pragma unroll
                    for (int n = 0; n < 2; ++n) acc[a][b][m][n] = (f32x4){0.f, 0.f, 0.f, 0.f};
        cur = nxt; cA = nA; cB = nB; ++ui;
        if constexpr (ALIGN_EPI) { if (wr == 1) PG8_BAR; }
    }
    PG8_WAIT_V(0);
    if constexpr (!ALIGN_EPI) { if (wr == 0) PG8_BAR; }
    PG8_BAR;
    if constexpr (Epi::AFTER_DRAIN) { E.fused(acc, cur, wr, wc, fr, fq, lds, wid, lane); S.done(cur); }
#undef PG8_SA
#undef PG8_SB
#undef PG8_STAGE
#undef PG8_LDA
#undef PG8_LDB
#undef PG8_MMA
#undef PG8_WAIT_V
#undef PG8_WAIT_L
#undef PG8_BAR
#undef PG8_SCHED
}
}
#define LAS __attribute__((address_space(3)))
typedef unsigned short bf16;
typedef float f32x4 __attribute__((ext_vector_type(4)));
typedef float f32x16 __attribute__((ext_vector_type(16)));
typedef short bf16x8 __attribute__((ext_vector_type(8)));
typedef short s16x4 __attribute__((ext_vector_type(4)));
typedef unsigned u32x2 __attribute__((ext_vector_type(2)));
typedef unsigned u32x4 __attribute__((ext_vector_type(4)));

#ifndef MK_COOP
#define MK_COOP 1
#endif

constexpr int NB = 16, SEQ = 2048, NMETA = 16, L = SEQ + NMETA, D = 1024, M = NB * L;
constexpr int DFF = 2816, NH = 16, NZ = 3072;
constexpr float EPS = 1e-6f;
constexpr float QSCALE = 0.10206207261596577f * 1.4426950408889634f;
constexpr int NPHASE = 18;

constexpr size_t MiB = (size_t)1 << 20;
constexpr size_t WS_BAR = 512 * 1024;
constexpr size_t WS_COS = 0, WS_SIN = 256 * 1024, WS_SS = 1 * MiB, WS_HM = 4 * MiB, WS_KR = 5 * MiB, WS_W = 8 * MiB, W_LAYER = 32 * MiB;
constexpr size_t W_IN = 0, W_UQ = 6 * MiB, W_UKV = 7 * MiB, W_C = 8 * MiB, W_PB = 9 * MiB, W_O = 11 * MiB, W_GU = 13 * MiB, W_D = 24 * MiB;
constexpr size_t WS_HB = 72 * MiB;
constexpr size_t OUT_Y = 0, OUT_CQ = 33 * MiB, OUT_CKV = 50 * MiB, OUT_AO = 0;
constexpr size_t WS_ZG = 137 * MiB, WS_BIG = 266 * MiB, WS_Q = WS_BIG, WS_KV = WS_BIG + 97 * MiB, WS_Z1 = WS_BIG, WS_MG = WS_BIG, WS_ACT = WS_BIG;
constexpr size_t WS_END = 492 * MiB;
static_assert(WS_SS + (size_t)M * 16 * 4 <= WS_HM && WS_KR + (size_t)M * 32 * 2 <= WS_W && WS_W + 2 * W_LAYER <= WS_HB, "ws map 1");
static_assert(WS_HB + (size_t)M * 1024 * 2 <= WS_ZG && WS_ZG + (size_t)M * 2048 * 2 <= WS_BIG && WS_Q + (size_t)M * 1536 * 2 <= WS_KV && WS_KV + (size_t)M * 2048 * 2 <= WS_END, "ws map 2");
static_assert(WS_ACT + (size_t)M * DFF * 2 <= WS_END && OUT_CKV + (size_t)M * 128 * 2 <= (size_t)128 * MiB && OUT_CQ + (size_t)M * 256 * 2 <= OUT_CKV && OUT_Y + (size_t)M * 512 * 2 <= OUT_CQ && OUT_AO + (size_t)M * 1024 * 2 <= (size_t)128 * MiB, "ws map 3");
static_assert(W_D + (size_t)1024 * DFF * 2 <= W_LAYER, "ws map 4");

struct Params {
    const float* in[18];
    float* out; unsigned char* ws;
    int ph_lo, ph_hi;
};

__device__ __forceinline__ const float* INP(const Params& p, int i) { asm volatile("" : "+s"(i)); return p.in[i]; }
__device__ __forceinline__ unsigned pk2(float lo, float hi) {
    typedef float f2_t __attribute__((ext_vector_type(2))); typedef __bf16 b2_t __attribute__((ext_vector_type(2)));
    f2_t v = {lo, hi}; b2_t b = __builtin_convertvector(v, b2_t); return __builtin_bit_cast(unsigned, b);
}
__device__ __forceinline__ float bflo(unsigned w) { return __uint_as_float(w << 16); }
__device__ __forceinline__ float bfhi(unsigned w) { return __uint_as_float(w & 0xffff0000u); }
__device__ __forceinline__ float bf1(bf16 x) { return __uint_as_float((unsigned)x << 16); }
__device__ __forceinline__ float wave_sum(float v) {
#pragma unroll
    for (int o = 1; o < 64; o <<= 1) v += __shfl_xor(v, o);
    return v;
}
__device__ __forceinline__ float sigmoidf_(float x) { return __builtin_amdgcn_rcpf(1.0f + __builtin_amdgcn_exp2f(-1.4426950408889634f * x)); }
__device__ __forceinline__ float row_rstd(const float* ss, int row) {
    const f32x4* p = (const f32x4*)(ss + (size_t)row * 16); const f32x4 a = p[0], b = p[1], c = p[2], d = p[3];
    const float s = ((a.x + a.y) + (a.z + a.w)) + ((b.x + b.y) + (b.z + b.w)) + ((c.x + c.y) + (c.z + c.w)) + ((d.x + d.y) + (d.z + d.w));
    return rsqrtf(s * (1.0f / 1024.0f) + EPS);
}

namespace pg8 {
#define EPI_ROW(ai, m) (u.pm * 256 + (ai) * 128 + wr * 64 + (m) * 16 + fr)
#define EPI_COL8(bj) (u.pn * 256 + (bj) * 128 + wc * 32 + 8 * fq)
#define EPI_LOOP_ROWS _Pragma("unroll") for (int ai = 0; ai < 2; ++ai) _Pragma("unroll") for (int m = 0; m < 4; ++m)
#define EPI_LOOP_BJ _Pragma("unroll") for (int bj = 0; bj < 2; ++bj)
typedef unsigned u32x2e __attribute__((ext_vector_type(2)));
__device__ __forceinline__ u32x4 pack8(const f32x4 a, const f32x4 b) { u32x4 w; w.x = pk2(a[0], a[1]); w.y = pk2(a[2], a[3]); w.z = pk2(b[0], b[1]); w.w = pk2(b[2], b[3]); return w; }
__device__ __forceinline__ f32x4 unlo(const u32x4 w) { return (f32x4){bflo(w.x), bfhi(w.x), bflo(w.y), bfhi(w.y)}; }
__device__ __forceinline__ f32x4 unhi(const u32x4 w) { return (f32x4){bflo(w.z), bfhi(w.z), bflo(w.w), bfhi(w.w)}; }
__device__ __forceinline__ f32x4 sig4(const f32x4 v) { return (f32x4){sigmoidf_(v[0]), sigmoidf_(v[1]), sigmoidf_(v[2]), sigmoidf_(v[3])}; }

struct EpiZ {
    static constexpr bool PERM = true, AFTER_DRAIN = false;
    const float* ss; bf16_t* z1; bf16_t* zg;
    __device__ __forceinline__ void operator()(const f32x4 (&acc)[2][2][4][2], const Unit& u, int wr, int wc, int fr, int fq) const {
        const bool gate = u.pn >= 4;
        EPI_LOOP_ROWS { const int row = EPI_ROW(ai, m); const float rs = row_rstd(ss, row);
            EPI_LOOP_BJ { const int col = EPI_COL8(bj); f32x4 v0 = acc[ai][bj][m][0] * rs, v1 = acc[ai][bj][m][1] * rs;
                if (gate) { *(u32x4*)(zg + (size_t)row * 2048 + (col - 1024)) = pack8(sig4(v0), sig4(v1)); }
                else { *(u32x4*)(z1 + (size_t)row * 1024 + col) = pack8(v0, v1); } } }
    }
};
struct EpiBf {
    static constexpr bool PERM = true, AFTER_DRAIN = false;
    bf16_t* o; int ldc;
    __device__ __forceinline__ void operator()(const f32x4 (&acc)[2][2][4][2], const Unit& u, int wr, int wc, int fr, int fq) const {
        EPI_LOOP_ROWS { const int row = EPI_ROW(ai, m);
            EPI_LOOP_BJ { *(u32x4*)(o + (size_t)row * ldc + EPI_COL8(bj)) = pack8(acc[ai][bj][m][0], acc[ai][bj][m][1]); } }
    }
};
struct EpiQ {
    static constexpr bool PERM = true, AFTER_DRAIN = false;
    bf16_t* q; const float* cs; const float* sn;
    __device__ __forceinline__ void operator()(const f32x4 (&acc)[2][2][4][2], const Unit& u, int wr, int wc, int fr, int fq) const {
        const bool rope = u.pn >= 4;
        EPI_LOOP_ROWS { const int row = EPI_ROW(ai, m); const int t = row % L;
            f32x4 c4 = {1.f, 1.f, 1.f, 1.f}, s4 = {0.f, 0.f, 0.f, 0.f};
            if (rope) { c4 = *(const f32x4*)(cs + t * 16 + 4 * fq); s4 = *(const f32x4*)(sn + t * 16 + 4 * fq); }
            EPI_LOOP_BJ { const f32x4 x1 = acc[ai][bj][m][0], x2 = acc[ai][bj][m][1]; f32x4 o1, o2;
                if (rope) { o1 = x1 * c4 - x2 * s4; o2 = x1 * s4 + x2 * c4; } else { o1 = x1; o2 = x2; }
                *(u32x4*)(q + (size_t)row * 1536 + EPI_COL8(bj)) = pack8(o1 * QSCALE, o2 * QSCALE); } }
    }
};
struct EpiTA {
    static constexpr bool PERM = true, AFTER_DRAIN = false;
    bf16_t* zg;
    __device__ __forceinline__ void operator()(const f32x4 (&acc)[2][2][4][2], const Unit& u, int wr, int wc, int fr, int fq) const {
        EPI_LOOP_ROWS { const int row = EPI_ROW(ai, m);
            EPI_LOOP_BJ { u32x4* p = (u32x4*)(zg + (size_t)row * 2048 + EPI_COL8(bj)); const u32x4 g = *p;
                *p = pack8(unlo(g) * acc[ai][bj][m][0], unhi(g) * acc[ai][bj][m][1]); } }
    }
};
struct EpiMG {
    static constexpr bool PERM = true, AFTER_DRAIN = false;
    const bf16_t* zg; bf16_t* mg;
    __device__ __forceinline__ void operator()(const f32x4 (&acc)[2][2][4][2], const Unit& u, int wr, int wc, int fr, int fq) const {
        EPI_LOOP_ROWS { const int row = EPI_ROW(ai, m);
            EPI_LOOP_BJ { const int col = EPI_COL8(bj); const u32x4 ta = *(const u32x4*)(zg + (size_t)row * 2048 + col), gb = *(const u32x4*)(zg + (size_t)row * 2048 + 1024 + col);
                *(u32x4*)(mg + (size_t)row * 1024 + col) = pack8(unlo(ta) + unlo(gb) * acc[ai][bj][m][0], unhi(ta) + unhi(gb) * acc[ai][bj][m][1]); } }
    }
};
struct EpiRes {
    static constexpr bool PERM = true, AFTER_DRAIN = false;
    const float* x; const float* meta; bool first;
    bf16_t* hb; float* ss;
    __device__ __forceinline__ void operator()(const f32x4 (&acc)[2][2][4][2], const Unit& u, int wr, int wc, int fr, int fq) const {
        EPI_LOOP_ROWS { const int row = EPI_ROW(ai, m); const int b = row / L, t = row - b * L;
            const float* pi = t < NMETA ? meta + (size_t)t * D : x + ((size_t)b * SEQ + (t - NMETA)) * D;
            float s = 0.f;
            EPI_LOOP_BJ { const int col = EPI_COL8(bj); u32x4* ph = (u32x4*)(hb + (size_t)row * 1024 + col); f32x4 v0, v1;
                if (first) { v0 = *(const f32x4*)(pi + col); v1 = *(const f32x4*)(pi + col + 4); } else { const u32x4 h = *ph; v0 = unlo(h); v1 = unhi(h); }
                v0 = v0 + acc[ai][bj][m][0]; v1 = v1 + acc[ai][bj][m][1]; *ph = pack8(v0, v1);
                s += ((v0[0] * v0[0] + v0[1] * v0[1]) + (v0[2] * v0[2] + v0[3] * v0[3])) + ((v1[0] * v1[0] + v1[1] * v1[1]) + (v1[2] * v1[2] + v1[3] * v1[3])); }
            s += __shfl_xor(s, 16); s += __shfl_xor(s, 32);
            if (fq == 0) ss[(size_t)row * 16 + u.pn * 4 + wc] = s; }
    }
};
struct EpiSw {
    static constexpr bool PERM = true, AFTER_DRAIN = false;
    const float* ss; bf16_t* act;
    __device__ __forceinline__ void operator()(const f32x4 (&acc)[2][2][4][2], const Unit& u, int wr, int wc, int fr, int fq) const {
        EPI_LOOP_ROWS { const int row = EPI_ROW(ai, m); const float rs = row_rstd(ss, row);
            EPI_LOOP_BJ { const f32x4 g = acc[ai][bj][m][0] * rs, up = acc[ai][bj][m][1] * rs; const f32x4 a = g * sig4(g) * up;
                u32x2e w; w.x = pk2(a[0], a[1]); w.y = pk2(a[2], a[3]);
                *(u32x2e*)(act + (size_t)row * DFF + (EPI_COL8(bj) >> 1)) = w; } }
    }
};
}
__device__ __forceinline__ void tr_item(const float* sp, int ldsrc, const float* kscale, int k0, bf16* dst_n0, int K, LAS float* scr, int lane) {
#pragma unroll 8
    for (int i = 0; i < 32; ++i) { const int kk = 2 * i + (lane >> 5); float v = sp ? sp[(size_t)(k0 + kk) * ldsrc] : 0.f; if (kscale) v *= kscale[k0 + kk]; scr[kk * 33 + (lane & 31)] = v; }
    asm volatile("s_waitcnt lgkmcnt(0)" ::: "memory");
    const int c = lane & 7;
#pragma unroll
    for (int j = 0; j < 4; ++j) { const int n = (lane >> 3) + 8 * j; const LAS float* s = scr + (8 * c) * 33 + n;
        u32x4 o; o.x = pk2(s[0 * 33], s[1 * 33]); o.y = pk2(s[2 * 33], s[3 * 33]); o.z = pk2(s[4 * 33], s[5 * 33]); o.w = pk2(s[6 * 33], s[7 * 33]);
        *(u32x4*)(dst_n0 + (size_t)n * K + k0 + 8 * c) = o; }
    asm volatile("s_waitcnt lgkmcnt(0)" ::: "memory");
}

constexpr int I_IN = 16 * 96, I_UQ = 4 * 48, I_UKV = 2 * 64, I_PB = 16 * 32, I_O = 16 * 32, I_GU = 16 * 176, I_D = 44 * 32;
constexpr int I_LAYER = I_IN + I_UQ + I_UKV + I_PB + I_O + I_GU + I_D;

__device__ __forceinline__ void prologue(const Params& p, LAS unsigned char* lds) {
    int tid_ = threadIdx.x; asm volatile("" : "+v"(tid_));
    const int lane = tid_ & 63, wave = __builtin_amdgcn_readfirstlane(tid_ >> 6), gw = blockIdx.x * 8 + wave, NGW = gridDim.x * 8; (void)wave;
    unsigned char* ws = p.ws;
    LAS float* scr = (LAS float*)(lds + wave * 16384);
    const int nl = lane & 31;
    for (int it = gw; it < 2 * I_LAYER; it += NGW) {
        const int l = it / I_LAYER; int r = it - l * I_LAYER;
        unsigned char* wl = ws + WS_W + (size_t)l * W_LAYER;
        if (r < I_IN) { const int nblk = 96, kb = r / nblk, nb = r % nblk, n = nb * 32 + nl;
            const float* src = INP(p, 3) + (size_t)l * 1024 * 2976; const float* sp = n < 928 ? src + n : (n < 1024 ? nullptr : src + (n - 96));
            tr_item(sp, 2976, INP(p, 2) + l * 1024, kb * 64, (bf16*)(wl + W_IN) + (size_t)nb * 32 * 1024, 1024, scr, lane); continue; } r -= I_IN;
        if (r < I_UQ) { const int nblk = 48, kb = r / nblk, nb = r % nblk, n = nb * 32 + nl;
            const float* src = INP(p, 8) + (size_t)l * 256 * 1536; const int pp = n & 31, rd = (pp & 4) ? 16 + 4 * (pp >> 3) + (pp & 3) : 4 * (pp >> 3) + (pp & 3); const int sc = n < 1024 ? (n >> 6) * 96 + (n & 63) : ((n - 1024) >> 5) * 96 + 64 + rd;
            tr_item(src + sc, 1536, nullptr, kb * 64, (bf16*)(wl + W_UQ) + (size_t)nb * 32 * 256, 256, scr, lane); continue; } r -= I_UQ;
        if (r < I_UKV) { const int nblk = 64, kb = r / nblk, nb = r % nblk, n = nb * 32 + nl;
            const float* src = INP(p, 9) + (size_t)l * 128 * 2048;
            tr_item(src + n, 2048, nullptr, kb * 64, (bf16*)(wl + W_UKV) + (size_t)nb * 32 * 128, 128, scr, lane); continue; } r -= I_UKV;
        if (r < I_PB) { const int nblk = 32, kb = r / nblk, nb = r % nblk, n = nb * 32 + nl;
            const float* src = INP(p, 11) + (size_t)l * 1024 * 1024;
            tr_item(src + n, 1024, nullptr, kb * 64, (bf16*)(wl + W_PB) + (size_t)nb * 32 * 1024, 1024, scr, lane); continue; } r -= I_PB;
        if (r < I_O) { const int nblk = 32, kb = r / nblk, nb = r % nblk, n = nb * 32 + nl;
            const float* src = INP(p, 12) + (size_t)l * 1024 * 1024;
            tr_item(src + n, 1024, nullptr, kb * 64, (bf16*)(wl + W_O) + (size_t)nb * 32 * 1024, 1024, scr, lane); continue; } r -= I_O;
        if (r < I_GU) { const int nblk = 176, kb = r / nblk, nb = r % nblk;
            const float* src = ((nl & 4) ? INP(p, 15) : INP(p, 14)) + (size_t)l * 1024 * DFF + nb * 16 + 4 * (nl >> 3) + (nl & 3);
            tr_item(src, DFF, INP(p, 13) + l * 1024, kb * 64, (bf16*)(wl + W_GU) + (size_t)nb * 32 * 1024, 1024, scr, lane); continue; } r -= I_GU;
        { const int nblk = 32, kb = r / nblk, nb = r % nblk, n = nb * 32 + nl;
            const float* src = INP(p, 16) + (size_t)l * DFF * 1024;
            tr_item(src + n, 1024, nullptr, kb * 64, (bf16*)(wl + W_D) + (size_t)nb * 32 * DFF, DFF, scr, lane); }
    }
    { const int gt = gw * 64 + lane, NT = NGW * 64;
      for (int idx = gt; idx < 2 * 65536; idx += NT) {
          const int l = idx >> 16, r = idx & 65535, n = r & 1023, kc = r >> 10, g = kc >> 4, i0 = (kc & 15) * 8;
          const float* pw = INP(p, 4) + (size_t)l * 4 * 128 * 128 + (size_t)g * 128 * 128 + (size_t)i0 * 128;
          const float* psc = INP(p, 5) + l * 512 + g * 128;
          const float* wpa = INP(p, 10) + (size_t)l * 512 * 1024 + (size_t)g * 128 * 1024 + n;
          float a[8] = {0.f, 0.f, 0.f, 0.f, 0.f, 0.f, 0.f, 0.f};
          for (int j = 0; j < 128; ++j) { const float w = psc[j] * wpa[(size_t)j * 1024];
#pragma unroll
              for (int e = 0; e < 8; ++e) a[e] += pw[e * 128 + j] * w; }
          u32x4 o; o.x = pk2(a[0], a[1]); o.y = pk2(a[2], a[3]); o.z = pk2(a[4], a[5]); o.w = pk2(a[6], a[7]);
          *(u32x4*)((bf16*)(ws + WS_W + (size_t)l * W_LAYER + W_C) + (size_t)n * 512 + kc * 8) = o; }
      float* cs = (float*)(ws + WS_COS); float* sn = (float*)(ws + WS_SIN);
      for (int idx = gt; idx < L * 16; idx += NT) { const int t = idx >> 4, i = idx & 15;
          const float inv = 1.0f / powf(10000.0f, (float)(2 * i) / 32.0f); const float ang = (float)t * inv;
          const double a = (double)ang; const double k = rint(a * 0.15915494309189535); const double rr = a - k * 6.283185307179586;
          const double r2 = rr * rr;
          double sv = rr * (1.0 + r2 * (-1.0/6 + r2 * (1.0/120 + r2 * (-1.0/5040 + r2 * (1.0/362880 + r2 * (-1.0/39916800 + r2 * (1.0/6227020800.0 + r2 * (-1.0/1307674368000.0 + r2 * (1.0/355687428096000.0)))))))));
          double cv = 1.0 + r2 * (-0.5 + r2 * (1.0/24 + r2 * (-1.0/720 + r2 * (1.0/40320 + r2 * (-1.0/3628800 + r2 * (1.0/479001600.0 + r2 * (-1.0/87178291200.0 + r2 * (1.0/20922789888000.0 + r2 * (-1.0/6402373705728000.0)))))))));
          cs[idx] = (float)cv; sn[idx] = (float)sv; }
    }
    { bf16* hb = (bf16*)(ws + WS_HB); float* ss = (float*)(ws + WS_SS);
      for (int m = gw; m < M; m += NGW) { const int b = m / L, t = m - b * L;
          const float* src = t < NMETA ? INP(p, 1) + (size_t)t * D : INP(p, 0) + ((size_t)b * SEQ + (t - NMETA)) * D;
          float s = 0.f;
#pragma unroll
          for (int j = 0; j < 4; ++j) { const f32x4 v = *(const f32x4*)(src + 256 * j + 4 * lane); s += (v[0] * v[0] + v[1] * v[1]) + (v[2] * v[2] + v[3] * v[3]);
              u32x2 w; w.x = pk2(v[0], v[1]); w.y = pk2(v[2], v[3]); *(u32x2*)(hb + (size_t)m * 1024 + 256 * j + 4 * lane) = w; }
          s = wave_sum(s);
          if (lane < 16) ss[(size_t)m * 16 + lane] = lane == 0 ? s : 0.f; }
    }
}

__device__ __forceinline__ void phase_elem(const Params& p, int l) {
    int tid_ = threadIdx.x; asm volatile("" : "+v"(tid_));
    const int lane = tid_ & 63, wave = __builtin_amdgcn_readfirstlane(tid_ >> 6), gw = blockIdx.x * 8 + wave, NGW = gridDim.x * 8; (void)wave;
    unsigned char* ws = p.ws;
    const bf16* Z1 = (const bf16*)(ws + WS_Z1); bf16* Y = (bf16*)((unsigned char*)p.out + OUT_Y); bf16* CQ = (bf16*)((unsigned char*)p.out + OUT_CQ); bf16* CKV = (bf16*)((unsigned char*)p.out + OUT_CKV); bf16* KR = (bf16*)(ws + WS_KR);
    const float* cs = (const float*)(ws + WS_COS); const float* sn = (const float*)(ws + WS_SIN);
    const float* qg = INP(p, 6) + l * 256; const float* kg = INP(p, 7) + l * 128;
    const f32x4 qg4 = *(const f32x4*)(qg + 4 * lane); const float kg0 = kg[2 * lane], kg1 = kg[2 * lane + 1];
    const int grp = lane >> 4, win = 2 << grp;
    for (int m = gw; m < M; m += NGW) { const int b = m / L, t = m - b * L; const bf16* z = Z1 + (size_t)m * 1024;
        { const u32x2 v = *(const u32x2*)(z + 512 + 4 * lane); const float a0 = bflo(v.x), a1 = bfhi(v.x), a2 = bflo(v.y), a3 = bfhi(v.y);
          const float s = wave_sum((a0 * a0 + a1 * a1) + (a2 * a2 + a3 * a3)); const float rs = rsqrtf(s * (1.0f / 256.0f) + EPS);
          u32x2 w; w.x = pk2(a0 * rs * qg4[0], a1 * rs * qg4[1]); w.y = pk2(a2 * rs * qg4[2], a3 * rs * qg4[3]); *(u32x2*)(CQ + (size_t)m * 256 + 4 * lane) = w; }
        { const unsigned v = *(const unsigned*)(z + 768 + 2 * lane); const float a0 = bflo(v), a1 = bfhi(v);
          const float s = wave_sum(a0 * a0 + a1 * a1); const float rs = rsqrtf(s * (1.0f / 128.0f) + EPS);
          *(unsigned*)(CKV + (size_t)m * 128 + 2 * lane) = pk2(a0 * rs * kg0, a1 * rs * kg1); }
        if (lane < 16) { const float x1 = bf1(z[896 + lane]), x2 = bf1(z[912 + lane]); const float c = cs[t * 16 + lane], s = sn[t * 16 + lane];
          const int kp = 8 * (lane >> 2) + (lane & 3); KR[(size_t)m * 32 + kp] = (bf16)(pk2(x1 * c - x2 * s, 0.f) & 0xffffu); KR[(size_t)m * 32 + kp + 4] = (bf16)(pk2(x1 * s + x2 * c, 0.f) & 0xffffu); }
        { const int cnt = (t + 1) < win ? (t + 1) : win; float sum[8], cur[8];
          { const u32x4 v = *(const u32x4*)(z + 8 * lane); cur[0] = bflo(v.x); cur[1] = bfhi(v.x); cur[2] = bflo(v.y); cur[3] = bfhi(v.y); cur[4] = bflo(v.z); cur[5] = bfhi(v.z); cur[6] = bflo(v.w); cur[7] = bfhi(v.w); }
#pragma unroll
          for (int e = 0; e < 8; ++e) sum[e] = cur[e];
#pragma unroll
          for (int j = 1; j < 16; ++j) if (j < cnt) { const u32x4 v = *(const u32x4*)(z - (size_t)j * 1024 + 8 * lane);
              sum[0] += bflo(v.x); sum[1] += bfhi(v.x); sum[2] += bflo(v.y); sum[3] += bfhi(v.y); sum[4] += bflo(v.z); sum[5] += bfhi(v.z); sum[6] += bflo(v.w); sum[7] += bfhi(v.w); }
          const float ic = 1.0f / (float)cnt; u32x4 o;
          o.x = pk2(sum[0] * ic - cur[0], sum[1] * ic - cur[1]); o.y = pk2(sum[2] * ic - cur[2], sum[3] * ic - cur[3]);
          o.z = pk2(sum[4] * ic - cur[4], sum[5] * ic - cur[5]); o.w = pk2(sum[6] * ic - cur[6], sum[7] * ic - cur[7]);
          *(u32x4*)(Y + (size_t)m * 512 + 8 * lane) = o; }
    }
}

__device__ __forceinline__ void phase_final(const Params& p) {
    int tid_ = threadIdx.x; asm volatile("" : "+v"(tid_));
    const int lane = tid_ & 63, wave = __builtin_amdgcn_readfirstlane(tid_ >> 6), gw = blockIdx.x * 8 + wave, NGW = gridDim.x * 8;
    const float* ss = (const float*)(p.ws + WS_SS); const float* g = INP(p, 17); const bf16* hb = (const bf16*)(p.ws + WS_HB);
    const f32x4 g0 = *(const f32x4*)(g + 8 * lane), g1 = *(const f32x4*)(g + 8 * lane + 4), g2 = *(const f32x4*)(g + 512 + 8 * lane), g3 = *(const f32x4*)(g + 512 + 8 * lane + 4);
    for (int r = gw; r < NB * SEQ; r += NGW) { const int b = r / SEQ, t = r - b * SEQ; const int m = b * L + NMETA + t;
        const float rs = row_rstd(ss, m); float* o = p.out + (size_t)r * D; const bf16* h = hb + (size_t)m * 1024;
        const u32x4 a = *(const u32x4*)(h + 8 * lane), c2 = *(const u32x4*)(h + 512 + 8 * lane);
        *(f32x4*)(o + 8 * lane) = pg8::unlo(a) * rs * g0; *(f32x4*)(o + 8 * lane + 4) = pg8::unhi(a) * rs * g1;
        *(f32x4*)(o + 512 + 8 * lane) = pg8::unlo(c2) * rs * g2; *(f32x4*)(o + 512 + 8 * lane + 4) = pg8::unhi(c2) * rs * g3; }
}

namespace att {
constexpr int KROW = 208, KBUF = 64 * KROW, VBUF = 8192, OFF_K = 0, OFF_V = 2 * KBUF, LDS_BYTES = 2 * KBUF + 2 * VBUF;
__device__ __forceinline__ int crow(int r, int hi) { return (r & 3) + 8 * (r >> 2) + 4 * hi; }
#define ATT_MFMA(a, b, c) __builtin_amdgcn_mfma_f32_32x32x16_bf16((a), (b), (c), 0, 0, 0)
typedef short v4i16_t __attribute__((ext_vector_type(4)));
__device__ __forceinline__ s16x4 vtr(const LAS unsigned char* p) { return __builtin_bit_cast(s16x4, __builtin_amdgcn_ds_read_tr16_b64_v4i16((LAS v4i16_t*)p)); }

__device__ __forceinline__ void attn_unit(LAS unsigned char* lds, const bf16* Q, const bf16* KV, const bf16* KR, bf16* AO, int b, int h, int qi) {
    int tid_ = threadIdx.x; asm volatile("" : "+v"(tid_));
    const int tid = tid_, lane = tid & 63, wid = tid >> 6, r32 = lane & 31, hi = lane >> 5;
    const int row0 = NMETA + 256 * (qi - 1), nt = 4 * qi + 1;
    const int qrow = row0 + 32 * wid + r32, qrc = qrow < 0 ? 0 : qrow;
    const size_t rb = (size_t)b * L;
    bf16x8 qf[6];
    { const bf16* qp = Q + (rb + qrc) * 1536;
#pragma unroll
      for (int d0 = 0; d0 < 4; ++d0) qf[d0] = *(const bf16x8*)(qp + h * 64 + 16 * d0 + 8 * hi);
#pragma unroll
      for (int d0 = 4; d0 < 6; ++d0) qf[d0] = *(const bf16x8*)(qp + 1024 + h * 32 + 16 * (d0 - 4) + 8 * hi); }
    const int lk = tid >> 3, lc = tid & 7, rk = (tid >> 2) & 63, rc = tid & 3;
    u32x4 pk_ = {0, 0, 0, 0}, pv_ = {0, 0, 0, 0}, pr_ = {0, 0, 0, 0};
#define ATT_GLOAD(kt) do { int kg = 64 * (kt) + lk; kg = kg > L - 1 ? L - 1 : kg; const bf16* kp = KV + (rb + kg) * 2048 + h * 128 + lc * 8; pk_ = *(const u32x4*)kp; pv_ = *(const u32x4*)(kp + 64); \
        if (tid < 256) { int kg2 = 64 * (kt) + rk; kg2 = kg2 > L - 1 ? L - 1 : kg2; pr_ = *(const u32x4*)(KR + (rb + kg2) * 32 + rc * 8); } } while (0)
#define ATT_LSTORE(bufi) do { *(LAS u32x4*)(lds + OFF_K + (bufi) * KBUF + lk * KROW + lc * 16) = pk_; *(LAS u32x4*)(lds + OFF_V + (bufi) * VBUF + (lc >> 2) * 4096 + lk * 64 + (lc & 3) * 16) = pv_; \
        if (tid < 256) *(LAS u32x4*)(lds + OFF_K + (bufi) * KBUF + rk * KROW + 128 + rc * 16) = pr_; } while (0)
    float mrun = 0.f, lrun = 0.f; f32x16 o0, o1, negm;
#pragma unroll
    for (int i = 0; i < 16; ++i) { o0[i] = 0.f; o1[i] = 0.f; negm[i] = 0.f; }
    ATT_GLOAD(0); ATT_LSTORE(0); __syncthreads();
    for (int kt = 0; kt < nt; ++kt) {
        const int buf = kt & 1;
        if (kt + 1 < nt) ATT_GLOAD(kt + 1);
        f32x16 p0, p1;
        const LAS unsigned char* kb = lds + OFF_K + buf * KBUF + r32 * KROW + hi * 16;
        { const bf16x8 a0 = *(const LAS bf16x8*)(kb), a1 = *(const LAS bf16x8*)(kb + 32 * KROW); p0 = ATT_MFMA(a0, qf[0], negm); p1 = ATT_MFMA(a1, qf[0], negm); }
#pragma unroll
        for (int d0 = 1; d0 < 6; ++d0) { const bf16x8 a0 = *(const LAS bf16x8*)(kb + d0 * 32), a1 = *(const LAS bf16x8*)(kb + 32 * KROW + d0 * 32);
            p0 = ATT_MFMA(a0, qf[d0], p0); p1 = ATT_MFMA(a1, qf[d0], p1); }
        if (64 * kt + 63 > row0 + 32 * wid) {
#pragma unroll
            for (int i = 0; i < 16; ++i) { const int key = 64 * kt + crow(i, hi); if (key > qrc) p0[i] = -INFINITY; if (key + 32 > qrc) p1[i] = -INFINITY; }
        }
        float mx = fmaxf(fmaxf(p0[0], p1[0]), fmaxf(p0[1], p1[1]));
#pragma unroll
        for (int i = 2; i < 16; i += 2) mx = fmaxf(mx, fmaxf(fmaxf(p0[i], p1[i]), fmaxf(p0[i + 1], p1[i + 1])));
        { auto rr = __builtin_amdgcn_permlane32_swap(__float_as_uint(mx), __float_as_uint(mx), false, false); mx = fmaxf(__uint_as_float(rr[0]), __uint_as_float(rr[1])); }
        if (kt == 0 || __any(mx > 8.0f)) {
            const float dl = kt == 0 ? mx : fmaxf(mx, 0.f); mrun += dl;
#pragma unroll
            for (int i = 0; i < 16; ++i) { p0[i] -= dl; p1[i] -= dl; negm[i] = -mrun; }
            const float alpha = kt == 0 ? 1.0f : __builtin_amdgcn_exp2f(-dl); lrun *= alpha;
#pragma unroll
            for (int i = 0; i < 16; ++i) { o0[i] *= alpha; o1[i] *= alpha; }
        }
        float ls0 = 0.f, ls1 = 0.f;
#pragma unroll
        for (int i = 0; i < 16; ++i) { p0[i] = __builtin_amdgcn_exp2f(p0[i]); p1[i] = __builtin_amdgcn_exp2f(p1[i]); ls0 += p0[i]; ls1 += p1[i]; }
        lrun += ls0 + ls1;
        bf16x8 pa[4];
#pragma unroll
        for (int s = 0; s < 2; ++s) { u32x4 w;
            w.x = pk2(p0[8 * s + 0], p0[8 * s + 1]); w.y = pk2(p0[8 * s + 2], p0[8 * s + 3]); w.z = pk2(p0[8 * s + 4], p0[8 * s + 5]); w.w = pk2(p0[8 * s + 6], p0[8 * s + 7]); pa[s] = __builtin_bit_cast(bf16x8, w);
            w.x = pk2(p1[8 * s + 0], p1[8 * s + 1]); w.y = pk2(p1[8 * s + 2], p1[8 * s + 3]); w.z = pk2(p1[8 * s + 4], p1[8 * s + 5]); w.w = pk2(p1[8 * s + 6], p1[8 * s + 7]); pa[2 + s] = __builtin_bit_cast(bf16x8, w); }
        const LAS unsigned char* vb = lds + OFF_V + buf * VBUF + (4 * hi + ((lane & 15) >> 2)) * 64 + ((lane >> 4) & 1) * 32 + (lane & 3) * 8;
#pragma unroll
        for (int ks = 0; ks < 4; ++ks) {
            const s16x4 l0 = vtr(vb + ks * 1024), h0 = vtr(vb + ks * 1024 + 512), l1 = vtr(vb + 4096 + ks * 1024), h1 = vtr(vb + 4096 + ks * 1024 + 512);
            const bf16x8 v0 = {l0[0], l0[1], l0[2], l0[3], h0[0], h0[1], h0[2], h0[3]}, v1 = {l1[0], l1[1], l1[2], l1[3], h1[0], h1[1], h1[2], h1[3]};
            o0 = ATT_MFMA(v0, pa[ks], o0); o1 = ATT_MFMA(v1, pa[ks], o1); }
        if (kt + 1 < nt) ATT_LSTORE(buf ^ 1);
        __syncthreads();
    }
    const float lt = lrun + __shfl_xor(lrun, 32), inv = 1.0f / lt;
    if (qrow >= 0) { bf16* op = AO + (rb + qrow) * 1024 + h * 64;
#pragma unroll
        for (int g = 0; g < 4; ++g) { u32x2 w0, w1;
            w0.x = pk2(o0[4 * g] * inv, o0[4 * g + 1] * inv); w0.y = pk2(o0[4 * g + 2] * inv, o0[4 * g + 3] * inv);
            w1.x = pk2(o1[4 * g] * inv, o1[4 * g + 1] * inv); w1.y = pk2(o1[4 * g + 2] * inv, o1[4 * g + 3] * inv);
            *(u32x2*)(op + 8 * g + 4 * hi) = w0; *(u32x2*)(op + 32 + 8 * g + 4 * hi) = w1; } }
#undef ATT_GLOAD
#undef ATT_LSTORE
}
}

#define XB_TMO      128
#define XB_XCNT(j)  (256  + 64 * (j))
#define XB_XSUB(j)  (1280 + 64 * (j))
#define XB_XGEN(j)  (2304 + 64 * (j))
#define XB_TOP      3328
#define XB_TOPGEN   3392
#define XCD_BAR_WORDS 3456
#define XB_SPIN_CAP (1u << 18)

__device__ __forceinline__ unsigned xb_ld(unsigned* p)              { return __hip_atomic_load(p, __ATOMIC_RELAXED, __HIP_MEMORY_SCOPE_AGENT); }
__device__ __forceinline__ unsigned xb_add(unsigned* p, unsigned v) { return __hip_atomic_fetch_add(p, v, __ATOMIC_RELAXED, __HIP_MEMORY_SCOPE_AGENT); }
__device__ __forceinline__ unsigned xb_xcc_id() { return (unsigned)__builtin_amdgcn_s_getreg((3 << 11) | 20) & 0xFu; }
#define XB_SPIN(cond, bar) do { unsigned _sp = 0; while (cond) { __builtin_amdgcn_s_sleep(1); \
    if ((++_sp & 255u) == 0u) { if (xb_ld(&(bar)[XB_TMO])) break; if (_sp > XB_SPIN_CAP) { atomicAdd(&(bar)[XB_TMO], 1u); break; } } } } while (0)

struct XcdBarrier {
    unsigned* bar; unsigned x;
    volatile LAS unsigned* st;
};

__device__ __forceinline__ XcdBarrier xcd_barrier_post(unsigned* bar, volatile LAS unsigned* st) {
    XcdBarrier b; b.bar = bar; b.x = xb_xcc_id(); b.st = st;
    if (threadIdx.x == 0) (void)xb_add(&bar[XB_XCNT(b.x)], 1u);
    return b;
}
__device__ __forceinline__ void xcd_barrier_complete(unsigned* bar, unsigned x, unsigned& nloc, unsigned& nx) {
    const unsigned G = gridDim.x * gridDim.y * gridDim.z;
    unsigned sum, cnt, mine, sp = 0u;
    for (;;) {
        sum = 0u; cnt = 0u; mine = 0u;
#pragma unroll
        for (unsigned j = 0; j < 16; ++j) { const unsigned c = xb_ld(&bar[XB_XCNT(j)]); sum += c; cnt += (c > 0u) ? 1u : 0u; mine = (j == x) ? c : mine; }
        if (sum == G) break;
        __builtin_amdgcn_s_sleep(1);
        if ((++sp & 255u) == 0u) { if (xb_ld(&bar[XB_TMO])) break; if (sp > XB_SPIN_CAP) { atomicAdd(&bar[XB_TMO], 1u); break; } }
    }
    nloc = mine > 0u ? mine : 1u; nx = cnt > 0u ? cnt : 1u;
}

__device__ __forceinline__ void xcd_barrier(const XcdBarrier& b) {
    asm volatile("s_waitcnt vmcnt(0)" ::: "memory");
    __syncthreads();
    if (threadIdx.x == 0) {
        unsigned* bar = b.bar;
        __builtin_amdgcn_s_waitcnt(0);
        unsigned nloc = b.st[0], nx = b.st[1];
        if (nloc == 0u) { xcd_barrier_complete(bar, b.x, nloc, nx); b.st[0] = nloc; b.st[1] = nx; }
        const unsigned old = xb_add(&bar[XB_XSUB(b.x)], 1u);
        const unsigned gen = old / nloc;
        if (old + 1u == (gen + 1u) * nloc) {
            __builtin_amdgcn_fence(__ATOMIC_RELEASE, "agent");
            asm volatile("s_waitcnt vmcnt(0)" ::: "memory");
            const unsigned og = xb_add(&bar[XB_TOP], 1u);
            const unsigned tg = og / nx;
            if (og + 1u == (tg + 1u) * nx) xb_add(&bar[XB_TOPGEN], 1u);
            else XB_SPIN(xb_ld(&bar[XB_TOPGEN]) == tg, bar);
            __builtin_amdgcn_fence(__ATOMIC_ACQUIRE, "agent");
            xb_add(&bar[XB_XGEN(b.x)], 1u);
            asm volatile("s_waitcnt vmcnt(0)" ::: "memory");
        } else {
            XB_SPIN(xb_ld(&bar[XB_XGEN(b.x)]) == gen, bar);
            __builtin_amdgcn_fence(__ATOMIC_ACQUIRE, "agent");
            asm volatile("s_waitcnt vmcnt(0)" ::: "memory");
        }
    }
    __syncthreads();
}

#ifndef DUP_MASK
#define DUP_MASK 0
#endif
constexpr int LDS_BYTES = 131072 + 1024;
__global__ void __launch_bounds__(512, 2) mk_fwd(Params p) {
    extern __shared__ __attribute__((aligned(16))) unsigned char lds_raw[];
    LAS unsigned char* lds = (LAS unsigned char*)lds_raw;
    const int G = gridDim.x;
    volatile LAS unsigned* bst = (volatile LAS unsigned*)(lds + 131072 + 512);
    if (threadIdx.x < 2) bst[threadIdx.x] = 0u;
    __syncthreads();
    XcdBarrier bar = xcd_barrier_post((unsigned*)(p.ws + WS_BAR), bst);
    unsigned char* ws = p.ws;
    const int lo = p.ph_lo, hi = p.ph_hi;
#define IN(k) (lo <= (k) && (k) < hi)
#define SEAM(k) do { if (IN(k) && IN((k) + 1)) { if ((k) == 0) cg::this_grid().sync(); else xcd_barrier(bar); } } while (0)
    bf16* HB = (bf16*)(ws + WS_HB); float* SS = (float*)(ws + WS_SS); bf16* ZG = (bf16*)(ws + WS_ZG);

    if (IN(0)) for (int rep_ = 0; rep_ < 1 + ((DUP_MASK >> 8) & 1); ++rep_) { if (rep_) xcd_barrier(bar); prologue(p, lds); }
    SEAM(0);
    for (int l = 0; l < 2; ++l) {
        const int pb = 1 + 8 * l;
        unsigned char* wl = ws + WS_W + (size_t)l * W_LAYER;
        if (IN(pb + 0)) for (int rep_ = 0; rep_ < 1 + ((DUP_MASK >> 0) & 1); ++rep_) { if (rep_) xcd_barrier(bar);
            pg8::Gemm g{HB, (const bf16*)(wl + W_IN), M, NZ, 1024}; pg8::StaticOrder S; S.init(M, NZ, G, (int)blockIdx.x);
            pg8::EpiZ E{SS, (bf16*)(ws + WS_Z1), ZG};
            pg8::gemm_phase<pg8::EpiZ, pg8::StaticOrder, true, true>(lds, g, S, E);
        }
        SEAM(pb + 0);
        if (IN(pb + 1)) for (int rep_ = 0; rep_ < 1 + ((DUP_MASK >> 1) & 1); ++rep_) { if (rep_) xcd_barrier(bar); phase_elem(p, l); }
        SEAM(pb + 1);
        if (IN(pb + 2)) for (int rep_ = 0; rep_ < 1 + ((DUP_MASK >> 2) & 1); ++rep_) { if (rep_) xcd_barrier(bar);
            { pg8::Gemm g{(const bf16*)((unsigned char*)p.out + OUT_CQ), (const bf16*)(wl + W_UQ), M, 1536, 256}; pg8::StaticOrder S; S.init(M, 1536, G, (int)blockIdx.x);
              pg8::EpiQ E{(bf16*)(ws + WS_Q), (const float*)(ws + WS_COS), (const float*)(ws + WS_SIN)};
              pg8::gemm_phase<pg8::EpiQ, pg8::StaticOrder, true, true>(lds, g, S, E); }
            { pg8::Gemm g{(const bf16*)((unsigned char*)p.out + OUT_CKV), (const bf16*)(wl + W_UKV), M, 2048, 128}; pg8::StaticOrder S; S.init(M, 2048, G, (int)blockIdx.x);
              pg8::EpiBf E{(bf16*)(ws + WS_KV), 2048};
              pg8::gemm_phase<pg8::EpiBf, pg8::StaticOrder, true, true>(lds, g, S, E); }
            { pg8::Gemm g{(const bf16*)((unsigned char*)p.out + OUT_Y), (const bf16*)(wl + W_C), M, 1024, 512}; pg8::StaticOrder S; S.init(M, 1024, G, (int)blockIdx.x);
              pg8::EpiTA E{ZG};
              pg8::gemm_phase<pg8::EpiTA, pg8::StaticOrder, true, true>(lds, g, S, E); }
        }
        SEAM(pb + 2);
        if (IN(pb + 3)) for (int rep_ = 0; rep_ < 1 + ((DUP_MASK >> 3) & 1); ++rep_) { if (rep_) xcd_barrier(bar);
            for (int bh = blockIdx.x; bh < NB * NH; bh += G)
                for (int qi = 8; qi >= 0; --qi)
                    att::attn_unit(lds, (const bf16*)(ws + WS_Q), (const bf16*)(ws + WS_KV), (const bf16*)(ws + WS_KR), (bf16*)((unsigned char*)p.out + OUT_AO), bh / NH, bh % NH, qi);
        }
        SEAM(pb + 3);
        if (IN(pb + 4)) for (int rep_ = 0; rep_ < 1 + ((DUP_MASK >> 4) & 1); ++rep_) { if (rep_) xcd_barrier(bar);
            pg8::Gemm g{(const bf16*)((unsigned char*)p.out + OUT_AO), (const bf16*)(wl + W_PB), M, 1024, 1024}; pg8::StaticOrder S; S.init(M, 1024, G, (int)blockIdx.x);
            pg8::EpiMG E{ZG, (bf16*)(ws + WS_MG)};
            pg8::gemm_phase<pg8::EpiMG, pg8::StaticOrder, true, true>(lds, g, S, E);
        }
        SEAM(pb + 4);
        if (IN(pb + 5)) for (int rep_ = 0; rep_ < 1 + (((DUP_MASK >> 5) & 1) && l == 0 ? 1 : 0); ++rep_) { if (rep_) xcd_barrier(bar);
            pg8::Gemm g{(const bf16*)(ws + WS_MG), (const bf16*)(wl + W_O), M, 1024, 1024}; pg8::StaticOrder S; S.init(M, 1024, G, (int)blockIdx.x);
            pg8::EpiRes E{INP(p, 0), INP(p, 1), l == 0, HB, SS};
            pg8::gemm_phase<pg8::EpiRes, pg8::StaticOrder, true, true>(lds, g, S, E);
        }
        SEAM(pb + 5);
        if (IN(pb + 6)) for (int rep_ = 0; rep_ < 1 + ((DUP_MASK >> 6) & 1); ++rep_) { if (rep_) xcd_barrier(bar);
            pg8::Gemm g{HB, (const bf16*)(wl + W_GU), M, 2 * DFF, 1024}; pg8::StaticOrder S; S.init(M, 2 * DFF, G, (int)blockIdx.x);
            pg8::EpiSw E{SS, (bf16*)(ws + WS_ACT)};
            pg8::gemm_phase<pg8::EpiSw, pg8::StaticOrder, true, true>(lds, g, S, E);
        }
        SEAM(pb + 6);
        if (IN(pb + 7)) for (int rep_ = 0; rep_ < 1 + ((DUP_MASK >> 7) & 1); ++rep_) { if (rep_) xcd_barrier(bar);
            pg8::Gemm g{(const bf16*)(ws + WS_ACT), (const bf16*)(wl + W_D), M, 1024, DFF}; pg8::StaticOrder S; S.init(M, 1024, G, (int)blockIdx.x);
            pg8::EpiRes E{INP(p, 0), INP(p, 1), false, HB, SS};
            pg8::gemm_phase<pg8::EpiRes, pg8::StaticOrder, true, true>(lds, g, S, E);
        }
        SEAM(pb + 7);
    }
    if (IN(17)) { phase_final(p); }
#undef IN
#undef SEAM
}

extern "C" void kernel_launch(void* const* d_in, const int* in_sizes, int n_in, void* d_out, int out_size, void* d_ws, size_t ws_size, hipStream_t stream) {
    static int grid = 0;
    if (grid == 0) {
        if (n_in != 18 || out_size != NB * SEQ * D || ws_size < WS_END) { fprintf(stderr, "kernel_launch: unexpected shapes (n_in %d out %d ws %zu need %zu)\n", n_in, out_size, ws_size, (size_t)WS_END); grid = -1; return; }
        int dev = 0, cus = 0, per_cu = 0;
        hipGetDevice(&dev); hipDeviceGetAttribute(&cus, hipDeviceAttributeMultiprocessorCount, dev);
        if (hipFuncSetAttribute((const void*)mk_fwd, hipFuncAttributeMaxDynamicSharedMemorySize, LDS_BYTES) != hipSuccess) { fprintf(stderr, "kernel_launch: hipFuncSetAttribute failed\n"); grid = -1; return; }
        if (hipOccupancyMaxActiveBlocksPerMultiprocessor(&per_cu, (const void*)mk_fwd, 512, LDS_BYTES) != hipSuccess || per_cu < 1) { fprintf(stderr, "kernel_launch: occupancy query says %d\n", per_cu); per_cu = 1; }
        (void)hipGetLastError();
        grid = cus;
    }
    if (grid < 0) return;
    Params p{};
    for (int i = 0; i < 18; ++i) p.in[i] = (const float*)d_in[i];
    p.out = (float*)d_out; p.ws = (unsigned char*)d_ws;
    if (hipMemsetAsync((char*)d_ws + WS_BAR, 0, XCD_BAR_WORDS * 4, stream) != hipSuccess) { fprintf(stderr, "kernel_launch: memset of the barrier words failed\n"); return; }
#if MK_COOP
    p.ph_lo = 0; p.ph_hi = NPHASE;
    void* args[] = {&p};
    hipError_t e = hipLaunchCooperativeKernel((const void*)mk_fwd, dim3(grid), dim3(512), args, LDS_BYTES, stream);
    if (e != hipSuccess) fprintf(stderr, "kernel_launch: cooperative launch failed: %s (grid %d)\n", hipGetErrorString(e), grid);
#else
    for (int k = 0; k < NPHASE; ++k) { p.ph_lo = k; p.ph_hi = k + 1; hipLaunchKernelGGL(mk_fwd, dim3(grid), dim3(512), LDS_BYTES, stream, p); }
#endif
}
```
